# Optimizing an MI355X kernel written in HIP

```python
import jax, jax.numpy as jnp
from jax import lax
import numpy as np

D_MODEL = 2048
BATCH = 4
SEQ = 4096
DEPTH = 1

GRID_W = 64
CTX_LEN = 256
EPS = 1e-6

M_HEADS = 8
M_DQK = 128
M_DV = 256
M_CONV = 5
M_CHUNK = 64
FGATE_BIAS_LO = 3.0
FGATE_BIAS_HI = 6.0

A_HEADS = 16
A_NOPE = 128
A_ROPE = 64
A_QK = A_NOPE + A_ROPE
A_DV = 128
KV_RANK = 512
ROPE_FREQS = A_ROPE // 4
ROPE_THETA = 10000.0
Q_BLOCK = 128

M_QK_W = M_HEADS * M_DQK
M_V_W = M_HEADS * M_DV
M_GATE_W = 4 * M_HEADS
A_Q_W = A_HEADS * A_QK
A_V_W = A_HEADS * A_DV
KV_SIZES = (M_QK_W, M_V_W, M_GATE_W, KV_RANK, A_ROPE)
Q_SIZES = (M_QK_W, M_V_W, M_V_W, A_Q_W, A_V_W, 2 * D_MODEL)
KV_COLS = M_QK_W + M_V_W + M_GATE_W + KV_RANK + A_ROPE
IN_COLS = KV_COLS + M_QK_W + M_V_W + M_V_W + A_Q_W + A_V_W + 2 * D_MODEL

kernel_name = "hybrid_mlstm_mla_prefix_block"


def split_cols(a, sizes):
    idx = np.cumsum(sizes)[:-1].tolist()
    return jnp.split(a, idx, axis=-1)


def rmsnorm(x, g):
    xf = x.astype(jnp.float32)
    y = xf * lax.rsqrt(jnp.mean(xf * xf, axis=-1, keepdims=True) + EPS)
    return (y * g.astype(jnp.float32)).astype(x.dtype)


def adaln(cvec, ada_w, ada_b):
    mod = jax.nn.silu(cvec) @ ada_w + ada_b
    return jnp.split(mod, 3, axis=-1)


def flip_seq(a):
    return jnp.flip(a, axis=2)


def centred_dwconv(x, w, b):
    k, ch = w.shape
    y = lax.conv_general_dilated(x, w[:, None, :].astype(x.dtype), window_strides=(1,),
                                 padding=[(k // 2, k // 2)],
                                 dimension_numbers=("NWC", "WIO", "NWC"),
                                 feature_group_count=ch)
    return y + b


def mlstm_heads(a, dh):
    b, t, _ = a.shape
    return a.reshape(b, t, -1, dh).transpose(0, 2, 1, 3)


def mlstm_qk(raw, w, b):
    return mlstm_heads(jax.nn.silu(centred_dwconv(raw, w, b)), M_DQK)


def mlstm_gates(raw, gate_b):
    b, t, _ = raw.shape
    g = (raw.astype(jnp.float32) + gate_b.astype(jnp.float32)).reshape(b, t, 4, M_HEADS)
    g = jnp.transpose(g, (2, 0, 3, 1))
    return (g[0], jax.nn.log_sigmoid(g[1]), g[2], jax.nn.log_sigmoid(g[3]))


def mlstm_zero_state(b):
    return (jnp.zeros((b, M_HEADS, M_DQK, M_DV), jnp.float32),
            jnp.zeros((b, M_HEADS, M_DQK), jnp.float32),
            jnp.zeros((b, M_HEADS), jnp.float32))


def mlstm_final_state(k, v, ig, lf):
    k = k.astype(jnp.float32)
    v = v.astype(jnp.float32)
    bcum = jnp.cumsum(lf, axis=-1)
    w_s = bcum[..., -1:] - bcum + ig
    m = jnp.max(w_s, axis=-1)
    ws = jnp.exp(w_s - m[..., None])
    c_state = jnp.einsum("bhs,bhsd,bhsv->bhdv", ws, k, v)
    n_state = jnp.einsum("bhs,bhsd->bhd", ws, k)
    return (c_state, n_state, m)


def mlstm_chunkwise(q, k, v, ig, lf, state0):
    b, h, t, _ = q.shape
    nc = t // M_CHUNK

    def to_chunks(a):
        a = a.astype(jnp.float32)
        return jnp.moveaxis(a.reshape(a.shape[:2] + (nc, M_CHUNK) + a.shape[3:]), 2, 0)

    xs = (to_chunks(q * (M_DQK ** -0.5)), to_chunks(k), to_chunks(v), to_chunks(ig), to_chunks(lf))
    mask = jnp.tril(jnp.ones((M_CHUNK, M_CHUNK), dtype=bool))

    def step(carry, inp):
        c_prev, n_prev, m_prev = carry
        qc, kc, vc, ic, fc = inp
        bcum = jnp.cumsum(fc, axis=-1)
        d = bcum[..., :, None] - bcum[..., None, :] + ic[..., None, :]
        d = jnp.where(mask, d, -jnp.inf)
        inter = bcum + m_prev[..., None]
        m_row = jnp.maximum(inter, jnp.max(d, axis=-1))
        s_inter = jnp.exp(inter - m_row)
        qk = jnp.einsum("bhtd,bhsd->bhts", qc, kc) * jnp.exp(d - m_row[..., None])
        num = (jnp.einsum("bhts,bhsv->bhtv", qk, vc)
               + s_inter[..., None] * jnp.einsum("bhtd,bhdv->bhtv", qc, c_prev))
        den = jnp.sum(qk, axis=-1) + s_inter * jnp.einsum("bhtd,bhd->bht", qc, n_prev)
        h_out = num / jnp.maximum(jnp.abs(den), jnp.exp(-m_row))[..., None]
        b_tot = bcum[..., -1]
        w_s = b_tot[..., None] - bcum + ic
        m_new = jnp.maximum(b_tot + m_prev, jnp.max(w_s, axis=-1))
        decay = jnp.exp(b_tot + m_prev - m_new)
        ws = jnp.exp(w_s - m_new[..., None])
        c_new = decay[..., None, None] * c_prev + jnp.einsum("bhs,bhsd,bhsv->bhdv", ws, kc, vc)
        n_new = decay[..., None] * n_prev + jnp.einsum("bhs,bhsd->bhd", ws, kc)
        return (c_new, n_new, m_new), h_out

    _, hs = lax.scan(step, state0, xs)
    return jnp.moveaxis(hs, 0, 2).reshape(b, h, t, M_DV)


def mlstm_bidir(q, k, v, gates, state_f, state_b):
    ig_f, lf_f, ig_b, lf_b = gates
    h_f = mlstm_chunkwise(q, k, v, ig_f, lf_f, state_f)
    h_b = flip_seq(mlstm_chunkwise(flip_seq(q), flip_seq(k), flip_seq(v),
                                   flip_seq(ig_b), flip_seq(lf_b), state_b))
    return h_f + h_b


def axial_angles(rows):
    row = jnp.repeat(jnp.arange(rows), GRID_W).astype(jnp.float32)
    col = jnp.tile(jnp.arange(GRID_W), rows).astype(jnp.float32)
    freqs = ROPE_THETA ** (-jnp.arange(ROPE_FREQS, dtype=jnp.float32) / ROPE_FREQS)
    return jnp.stack([row[:, None] * freqs, col[:, None] * freqs], axis=1)


def axial_rope(t, ang):
    b, s, h, _ = t.shape
    nope, rope = t[..., :A_NOPE], t[..., A_NOPE:]
    r = rope.reshape(b, s, h, 2, 2, ROPE_FREQS)
    cos = jnp.cos(ang)[None, :, None].astype(t.dtype)
    sin = jnp.sin(ang)[None, :, None].astype(t.dtype)
    x1, x2 = r[..., 0, :], r[..., 1, :]
    rot = jnp.stack([x1 * cos - x2 * sin, x1 * sin + x2 * cos], axis=-2).reshape(b, s, h, A_ROPE)
    return jnp.concatenate([nope, rot], axis=-1)


def mla_kv(ckv, k_rope, kv_norm_g, w_uk, w_uv, k_norm_g):
    b, t, _ = ckv.shape
    cn = rmsnorm(ckv, kv_norm_g)
    k_nope = (cn @ w_uk).reshape(b, t, A_HEADS, A_NOPE)
    v = (cn @ w_uv).reshape(b, t, A_HEADS, A_DV)
    k_r = jnp.broadcast_to(k_rope[:, :, None, :], (b, t, A_HEADS, A_ROPE))
    k = rmsnorm(jnp.concatenate([k_nope, k_r], axis=-1), k_norm_g)
    return k, v


def mla_q(qa, q_norm_g):
    b, t, _ = qa.shape
    return rmsnorm(qa.reshape(b, t, A_HEADS, A_QK), q_norm_g)


def block_attention(q, k, v):
    b, s, h, dh = q.shape
    nb = s // Q_BLOCK
    qb = jnp.moveaxis(q.reshape(b, nb, Q_BLOCK, h, dh), 1, 0)
    scale = dh ** -0.5

    def one_block(qblk):
        sc = jnp.einsum("bqhd,bkhd->bhqk", qblk, k, preferred_element_type=jnp.float32) * scale
        p = jax.nn.softmax(sc, axis=-1).astype(v.dtype)
        return jnp.einsum("bhqk,bkhd->bqhd", p, v)

    o = lax.map(one_block, qb)
    return jnp.moveaxis(o, 0, 1).reshape(b, s, h * v.shape[-1])


def merge_branches(h_m, o_gate, z_m, o_a, z_a, g_merge, mh_norm_g, w_proj_m, w_proj_a, w_out):
    b, _, t, _ = h_m.shape
    hm = rmsnorm(h_m.transpose(0, 2, 1, 3), mh_norm_g.reshape(M_HEADS, M_DV)).reshape(b, t, M_V_W)
    hm = hm.astype(z_m.dtype) * jax.nn.sigmoid(o_gate) * jax.nn.silu(z_m)
    p_m = hm @ w_proj_m
    p_a = (o_a * jax.nn.silu(z_a)) @ w_proj_a
    g_m, g_a = jnp.split(jax.nn.sigmoid(g_merge), 2, axis=-1)
    return (g_m * p_m + g_a * p_a) @ w_out


def hybrid_layer(x, ctx, c, c_ctx, ada_w, ada_b, norm_g, w_in, conv_w, conv_b, gate_b, mh_norm_g,
                 q_norm_g, k_norm_g, kv_norm_g, w_uk, w_uv, w_proj_m, w_proj_a, w_out, ang, update_ctx):
    shift, scale, gate = adaln(c, ada_w, ada_b)
    shift_c, scale_c, gate_c = adaln(c_ctx, ada_w, ada_b)
    h = rmsnorm(x, norm_g) * (1 + scale[:, None]) + shift[:, None]
    hc = rmsnorm(ctx, norm_g) * (1 + scale_c) + shift_c
    proj = h @ w_in
    proj_c = hc @ (w_in if update_ctx else w_in[:, :KV_COLS])
    cw_q, cw_k = conv_w[:, :M_QK_W], conv_w[:, M_QK_W:]
    cb_q, cb_k = conv_b[:M_QK_W], conv_b[M_QK_W:]

    km_c, vm_c, gt_c, ckv_c, kr_c = split_cols(proj_c[..., :KV_COLS], KV_SIZES)
    k_mc = mlstm_qk(km_c, cw_k, cb_k)
    v_mc = mlstm_heads(vm_c, M_DV)
    gates_c = mlstm_gates(gt_c, gate_b)
    state_f = mlstm_final_state(k_mc, v_mc, gates_c[0], gates_c[1])
    state_b = mlstm_final_state(flip_seq(k_mc), flip_seq(v_mc), flip_seq(gates_c[2]), flip_seq(gates_c[3]))
    k_ac, v_ac = mla_kv(ckv_c, kr_c, kv_norm_g, w_uk, w_uv, k_norm_g)

    km, vm, gt, ckv, kr = split_cols(proj[..., :KV_COLS], KV_SIZES)
    qm, om, zm, qa, za, gm = split_cols(proj[..., KV_COLS:], Q_SIZES)
    h_m = mlstm_bidir(mlstm_qk(qm, cw_q, cb_q), mlstm_qk(km, cw_k, cb_k), mlstm_heads(vm, M_DV),
                      mlstm_gates(gt, gate_b), state_f, state_b)
    k_al, v_al = mla_kv(ckv, kr, kv_norm_g, w_uk, w_uv, k_norm_g)
    k_al = axial_rope(k_al, ang)
    q_al = axial_rope(mla_q(qa, q_norm_g), ang)
    o_a = block_attention(q_al, jnp.concatenate([k_ac, k_al], axis=1),
                          jnp.concatenate([v_ac, v_al], axis=1))
    x = x + gate[:, None] * merge_branches(h_m, om, zm, o_a, za, gm, mh_norm_g, w_proj_m, w_proj_a, w_out)

    if update_ctx:
        qm_c, om_c, zm_c, qa_c, za_c, gm_c = split_cols(proj_c[..., KV_COLS:], Q_SIZES)
        zero = mlstm_zero_state(ctx.shape[0])
        h_mc = mlstm_bidir(mlstm_qk(qm_c, cw_q, cb_q), k_mc, v_mc, gates_c, zero, zero)
        o_ac = block_attention(mla_q(qa_c, q_norm_g), k_ac, v_ac)
        ctx = ctx + gate_c * merge_branches(h_mc, om_c, zm_c, o_ac, za_c, gm_c, mh_norm_g,
                                            w_proj_m, w_proj_a, w_out)
    return x, ctx


def setup_inputs(seed: int = 0) -> dict:
    key = jax.random.key(seed)
    ks = jax.random.split(key, 24)

    def nrm(k, shape, s):
        return jax.random.normal(k, shape, jnp.float32) * s

    fbias = jnp.linspace(FGATE_BIAS_LO, FGATE_BIAS_HI, M_HEADS, dtype=jnp.float32)
    gate_b = jnp.concatenate([
        nrm(ks[10], (DEPTH, M_HEADS), 0.1),
        fbias + nrm(ks[11], (DEPTH, M_HEADS), 0.1),
        nrm(ks[12], (DEPTH, M_HEADS), 0.1),
        fbias + nrm(ks[13], (DEPTH, M_HEADS), 0.1)], axis=-1)
    return {
        "x": nrm(ks[0], (BATCH, SEQ, D_MODEL), 1.0),
        "c": nrm(ks[1], (BATCH, D_MODEL), 1.0),
        "ctx": nrm(ks[2], (BATCH, CTX_LEN, D_MODEL), 1.0),
        "c_ctx": nrm(ks[3], (D_MODEL,), 1.0),
        "ada_w": nrm(ks[4], (DEPTH, D_MODEL, 3 * D_MODEL), 0.5 * D_MODEL ** -0.5),
        "ada_b": nrm(ks[5], (DEPTH, 3 * D_MODEL), 0.02),
        "norm_g": 1.0 + nrm(ks[6], (DEPTH, D_MODEL), 0.02),
        "w_in": nrm(ks[7], (DEPTH, D_MODEL, IN_COLS), D_MODEL ** -0.5),
        "conv_w": nrm(ks[8], (DEPTH, M_CONV, 2 * M_QK_W), M_CONV ** -0.5),
        "conv_b": nrm(ks[9], (DEPTH, 2 * M_QK_W), 0.02),
        "gate_b": gate_b,
        "mh_norm_g": 1.0 + nrm(ks[14], (DEPTH, M_V_W), 0.02),
        "q_norm_g": 1.0 + nrm(ks[15], (DEPTH, A_QK), 0.02),
        "k_norm_g": 1.0 + nrm(ks[16], (DEPTH, A_QK), 0.02),
        "kv_norm_g": 1.0 + nrm(ks[17], (DEPTH, KV_RANK), 0.02),
        "w_uk": nrm(ks[18], (DEPTH, KV_RANK, A_HEADS * A_NOPE), KV_RANK ** -0.5),
        "w_uv": nrm(ks[19], (DEPTH, KV_RANK, A_V_W), KV_RANK ** -0.5),
        "w_proj_m": nrm(ks[20], (DEPTH, M_V_W, D_MODEL), M_V_W ** -0.5),
        "w_proj_a": nrm(ks[21], (DEPTH, A_V_W, D_MODEL), A_V_W ** -0.5),
        "w_out": nrm(ks[22], (DEPTH, D_MODEL, D_MODEL), D_MODEL ** -0.5),
    }


def reference(x, c, ctx, c_ctx, ada_w, ada_b, norm_g, w_in, conv_w, conv_b, gate_b, mh_norm_g,
              q_norm_g, k_norm_g, kv_norm_g, w_uk, w_uv, w_proj_m, w_proj_a, w_out):
    rows = x.shape[1] // GRID_W
    ang = axial_angles(rows)
    for layer in range(DEPTH):
        x, ctx = hybrid_layer(x, ctx, c, c_ctx, ada_w[layer], ada_b[layer], norm_g[layer], w_in[layer],
                              conv_w[layer], conv_b[layer], gate_b[layer], mh_norm_g[layer],
                              q_norm_g[layer], k_norm_g[layer], kv_norm_g[layer], w_uk[layer],
                              w_uv[layer], w_proj_m[layer], w_proj_a[layer], w_out[layer], ang,
                              layer + 1 < DEPTH)
    return x
```

```cpp
#include <hip/hip_runtime.h>
#include <hip/hip_cooperative_groups.h>
#include <cstdio>
namespace cg = cooperative_groups;

#define LAS __attribute__((address_space(3)))
typedef unsigned short bf16_t;
typedef short bf16x8 __attribute__((ext_vector_type(8)));
typedef short s16x4 __attribute__((ext_vector_type(4)));
typedef float f32x4 __attribute__((ext_vector_type(4)));
typedef float f32x2 __attribute__((ext_vector_type(2)));
typedef float f32x16 __attribute__((ext_vector_type(16)));
typedef unsigned u32x4 __attribute__((ext_vector_type(4)));
typedef unsigned u32x2 __attribute__((ext_vector_type(2)));

constexpr int DM = 2048, NB = 4, SEQ = 4096, NT = NB * SEQ  , CL = 256, NC = NB * CL  , NR = NT + NC  , SKV = SEQ + CL  ;
constexpr int IN_COLS = 18016;
constexpr float EPS = 1e-6f;
constexpr int NTHR = 512;
constexpr int LDS_BYTES = 141312 + 16;

constexpr size_t al256(size_t x) { return (x + 255) / 256 * 256; }
constexpr size_t WS_MOD   = 0;
constexpr size_t WS_WUKV  = al256(WS_MOD + 5 * 6144 * 4);
constexpr size_t WS_WPM   = WS_WUKV + (size_t)4096 * 512 * 2;
constexpr size_t WS_WPA   = WS_WPM + (size_t)2048 * 2048 * 2;
constexpr size_t WS_WOUT  = WS_WPA + (size_t)2048 * 2048 * 2;
constexpr size_t WS_KM    = WS_WOUT + (size_t)2048 * 2048 * 2;
constexpr size_t WS_QM    = WS_KM + (size_t)NR * 1024 * 2;
constexpr size_t WS_VM    = WS_QM + (size_t)NT * 1024 * 2;
constexpr size_t WS_KRGT  = WS_VM + (size_t)NR * 2048 * 2;
constexpr size_t WS_CKV   = WS_KRGT + (size_t)NR * 96 * 4;
constexpr size_t WS_GMZ   = WS_CKV + (size_t)NR * 512 * 2;
constexpr size_t WS_QA    = WS_GMZ + (size_t)NT * 2048 * 2;
constexpr size_t WS_ZA    = WS_QA + (size_t)NT * 3072 * 2;
constexpr size_t WS_H     = WS_ZA + (size_t)NT * 2048 * 2;
constexpr int LDH = 2048 + 64;
constexpr size_t WS_WIN   = WS_H + (size_t)NR * LDH * 2;
constexpr size_t WS_END   = WS_WIN + (size_t)71 * 256 * LDH * 2;
constexpr size_t WS_KC    = WS_H;
constexpr size_t WS_QC    = WS_KC + (size_t)NR * 1024 * 2;
constexpr size_t WS_HF    = WS_KM;
constexpr size_t WS_HB    = WS_QC + (size_t)NT * 1024 * 2;
static_assert(WS_HF + (size_t)NT * 2048 * 2 <= WS_VM, "HF alias");
constexpr size_t WS_KB    = WS_H;
constexpr size_t WS_V2    = WS_KM;
constexpr size_t WS_U     = WS_KM + (size_t)NR * 2048 * 2;
static_assert(WS_HB + (size_t)NT * 2048 * 2 <= WS_END, "HF/HB alias");
static_assert(WS_KB + (size_t)NR * 3072 * 2 <= WS_END, "KB alias");
static_assert(WS_U + (size_t)NT * 2048 * 2 <= WS_KRGT, "U alias");
constexpr size_t WS_BAR   = WS_END;
static_assert(WS_BAR + 16384 <= 590348288ull, "workspace");

struct Params {
    const float *x, *c, *ctx, *c_ctx, *ada_w, *ada_b, *norm_g, *w_in, *conv_w, *conv_b, *gate_b, *mh_norm_g, *q_norm_g, *k_norm_g, *kv_norm_g,
                *w_uk, *w_uv, *w_proj_m, *w_proj_a, *w_out;
    float* out; unsigned char* ws; int ph_lo, ph_hi;
};

typedef __bf16 bf16x2_t __attribute__((ext_vector_type(2)));
__device__ __forceinline__ unsigned cvt_pk_bf16(float lo, float hi) { const f32x2 v = {lo, hi}; const bf16x2_t b = __builtin_convertvector(v, bf16x2_t); return __builtin_bit_cast(unsigned, b); }
__device__ __forceinline__ float bf2f(unsigned short b) { return __uint_as_float(((unsigned)b) << 16); }
__device__ __forceinline__ float bflo(unsigned w) { return __uint_as_float(w << 16); }
__device__ __forceinline__ float bfhi(unsigned w) { return __uint_as_float(w & 0xffff0000u); }
__device__ __forceinline__ float sigmoidf_(float x) { return __builtin_amdgcn_rcpf(1.0f + __expf(-x)); }
__device__ __forceinline__ float siluf_(float x) { return x * __builtin_amdgcn_rcpf(1.0f + __expf(-x)); }
__device__ __forceinline__ float wave_sum(float v) { for (int o = 32; o >= 1; o >>= 1) v += __shfl_xor(v, o); return v; }
__device__ __forceinline__ float wave_max(float v) { for (int o = 32; o >= 1; o >>= 1) v = fmaxf(v, __shfl_xor(v, o)); return v; }
namespace pg8 {
constexpr int BM = 256, BK = 64, HALF = 128, HTB = HALF * BK * 2, STAGE_BYTES = 8 * HTB, NXCD = 8, WGM = 8;
__host__ __device__ __forceinline__ int lds_byte(int r, int c) { const int st = (r >> 4) * 2 + (c >> 5), rr = r & 15, cc = c & 31, ob = rr * 64 + cc * 2; return st * 1024 + (ob ^ (((ob >> 9) & 1) << 5)); }
__host__ __device__ __forceinline__ void stage_rc(int b, int& R, int& C) { const int st = b / 1024, sb = b % 1024, swz = sb ^ (((sb >> 9) & 1) << 5); R = (st >> 1) * 16 + swz / 64; C = (st & 1) * 32 + (swz % 64) / 2; }
__host__ __device__ __forceinline__ int perm32(int rho) { const int n = rho >> 4, i = rho & 15; return 8 * (i >> 2) + 4 * n + (i & 3); }
struct Unit { int pm, pn; };
struct Gemm { const bf16_t* A; const bf16_t* Bt; int K; int ld; };
struct Order {
    int nM, nN, nwg, exN, total, G, c, wgm;
    __device__ void init(int nM_, int nN_, int exM, int exN_, int G_, int c_, int wgm_ = WGM) { nM = nM_; nN = nN_; nwg = nM * nN; exN = exN_; total = nwg + exM * exN_; G = G_; c = c_; wgm = wgm_; }
    __device__ bool next(int i, Unit& u) const {
        const long L = (long)i * G + c; if (L >= total) return false;
        if (L >= nwg) { const int idx = (int)L - nwg; u.pm = nM + idx / exN; u.pn = idx % exN; return true; }
        int wgid = (int)L; { const int q = nwg / NXCD, r = nwg % NXCD, xcd = wgid % NXCD, off = wgid / NXCD; wgid = (xcd < r ? xcd * (q + 1) : r * (q + 1) + (xcd - r) * q) + off; }
        const int nig = wgm * nN, gid = wgid / nig, fm = gid * wgm, gsz = (nM - fm) < wgm ? (nM - fm) : wgm;
        u.pm = fm + ((wgid % nig) % gsz); u.pn = (wgid % nig) / gsz; return true;
    }
};
template <class Epi>
__device__ __forceinline__ void gemm_phase(LAS unsigned char* lds, const Gemm g, const Order& S, const Epi& E) {
    const int tid = threadIdx.x, wid = __builtin_amdgcn_readfirstlane(tid >> 6), lane = tid & 63, wr = wid >> 2, wc = wid & 3, fr = lane & 15, fq = lane >> 4;
    const int K = g.K, nt = K / BK, LD = g.ld;
    unsigned voffA[2], voffB[2];
#pragma unroll
    for (int i = 0; i < 2; ++i) { int R, C; stage_rc(tid * 16 + i * 8192, R, C); const int Rb = (R & ~31) + perm32(R & 31);
        voffA[i] = (unsigned)(R * LD + C) * 2u; voffB[i] = (unsigned)(Rb * LD + C) * 2u; }
    const size_t kstep = (size_t)(BK * 2);
    const size_t hstep = (size_t)HALF * LD * 2;
    const size_t tstep = 2 * hstep;
    const unsigned ldsw = (unsigned)wid * 1024u;
    const int aoff = lds_byte(wr * 64 + fr, fq * 8), boff = lds_byte(wc * 32 + fr, fq * 8);
#define PG8_SA(b, h) (((b) * 2 + (h)) * HTB)
#define PG8_SB(b, h) ((4 + (b) * 2 + (h)) * HTB)
#define PG8_STAGE(bufoff, gbase, voff) do { _Pragma("unroll") for (int _i = 0; _i < 2; ++_i) \
        __builtin_amdgcn_global_load_lds((const unsigned*)((const char*)(gbase) + (voff)[_i]), (LAS unsigned*)(lds + (bufoff) + ldsw + _i * 8192), 16, 0, 0); } while (0)
#define PG8_LDA(dst, b, h) do { _Pragma("unroll") for (int m = 0; m < 4; ++m) _Pragma("unroll") for (int k = 0; k < 2; ++k) dst[m][k] = *(const LAS bf16x8*)(lds + PG8_SA(b, h) + aoff + m * 2048 + k * 1024); } while (0)
#define PG8_LDB(dst, b, h) do { _Pragma("unroll") for (int n = 0; n < 2; ++n) _Pragma("unroll") for (int k = 0; k < 2; ++k) dst[n][k] = *(const LAS bf16x8*)(lds + PG8_SB(b, h) + boff + n * 2048 + k * 1024); } while (0)
#define PG8_MMA(ai, bj, At, Bt) do { __builtin_amdgcn_s_setprio(1); _Pragma("unroll") for (int m = 0; m < 4; ++m) _Pragma("unroll") for (int n = 0; n < 2; ++n) _Pragma("unroll") for (int k = 0; k < 2; ++k) \
        acc[ai][bj][m][n] = __builtin_amdgcn_mfma_f32_16x16x32_bf16(Bt[n][k], At[m][k], acc[ai][bj][m][n], 0, 0, 0); __builtin_amdgcn_s_setprio(0); } while (0)
#define PG8_WAIT_V(n) asm volatile("s_waitcnt vmcnt(" #n ")" ::: "memory")
#define PG8_WAIT_L(n) asm volatile("s_waitcnt lgkmcnt(" #n ")" ::: "memory")
#define PG8_BAR __builtin_amdgcn_s_barrier()
#define PG8_SCHED __builtin_amdgcn_sched_barrier(0)
    Unit cur, nxt; int ui = 0;
    if (!S.next(0, cur)) return;
    f32x4 acc[2][2][4][2];
#pragma unroll
    for (int a = 0; a < 2; ++a)
#pragma unroll
        for (int b = 0; b < 2; ++b)
#pragma unroll
            for (int m = 0; m < 4; ++m)
#pragma unroll
                for (int n = 0; n < 2; ++n) acc[a][b][m][n] = (f32x4){0.f, 0.f, 0.f, 0.f};
    bf16x8 At[4][2], B0[2][2], B1[2][2];
    const char* cA = (const char*)g.A + (size_t)cur.pm * tstep; const char* cB = (const char*)g.Bt + (size_t)cur.pn * tstep;
    PG8_STAGE(PG8_SB(0, 0), cB, voffB); PG8_STAGE(PG8_SA(0, 0), cA, voffA); PG8_STAGE(PG8_SB(0, 1), cB + hstep, voffB); PG8_STAGE(PG8_SA(0, 1), cA + hstep, voffA);
    if (wr == 1) PG8_BAR;
    PG8_WAIT_V(4); PG8_BAR;
    PG8_STAGE(PG8_SB(1, 0), cB + kstep, voffB); PG8_STAGE(PG8_SA(1, 0), cA + kstep, voffA); PG8_STAGE(PG8_SB(1, 1), cB + hstep + kstep, voffB);
    PG8_WAIT_V(6); PG8_BAR;
    for (;;) {
        const bool has_next = S.next(ui + 1, nxt);
        const char* nA = has_next ? (const char*)g.A + (size_t)nxt.pm * tstep : cA; const char* nB = has_next ? (const char*)g.Bt + (size_t)nxt.pn * tstep : cB;
        for (int t = 0; t < nt; t += 2) {
            const bool last = (t == nt - 2);
            const char* a1 = cA + (size_t)(t + 1) * kstep;
            const char* a2 = last ? nA : cA + (size_t)(t + 2) * kstep; const char* b2 = last ? nB : cB + (size_t)(t + 2) * kstep;
            const char* a3 = a2 + kstep; const char* b3 = b2 + kstep;
            PG8_LDB(B0, 0, 0); PG8_SCHED; PG8_LDA(At, 0, 0); PG8_STAGE(PG8_SA(1, 1), a1 + hstep, voffA);
            PG8_WAIT_L(8); PG8_BAR; PG8_WAIT_L(0); PG8_MMA(0, 0, At, B0); PG8_BAR; PG8_SCHED;
            PG8_LDB(B1, 0, 1); PG8_STAGE(PG8_SB(0, 0), b2, voffB);
            PG8_BAR; PG8_WAIT_L(0); PG8_MMA(0, 1, At, B1); PG8_BAR;
            PG8_LDA(At, 0, 1); PG8_STAGE(PG8_SA(0, 0), a2, voffA);
            PG8_BAR; PG8_WAIT_L(0); PG8_MMA(1, 0, At, B0); PG8_BAR; PG8_SCHED;
            PG8_STAGE(PG8_SB(0, 1), b2 + hstep, voffB);
            PG8_WAIT_V(6); PG8_BAR; PG8_MMA(1, 1, At, B1); PG8_BAR;
            PG8_LDB(B0, 1, 0); PG8_SCHED; PG8_LDA(At, 1, 0); PG8_STAGE(PG8_SA(0, 1), a2 + hstep, voffA);
            PG8_WAIT_L(8); PG8_BAR; PG8_WAIT_L(0); PG8_MMA(0, 0, At, B0); PG8_BAR; PG8_SCHED;
            PG8_LDB(B1, 1, 1); PG8_STAGE(PG8_SB(1, 0), b3, voffB);
            PG8_BAR; PG8_WAIT_L(0); PG8_MMA(0, 1, At, B1); PG8_BAR;
            PG8_LDA(At, 1, 1); PG8_STAGE(PG8_SA(1, 0), a3, voffA);
            PG8_BAR; PG8_WAIT_L(0); PG8_MMA(1, 0, At, B0); PG8_BAR; PG8_SCHED;
            PG8_STAGE(PG8_SB(1, 1), b3 + hstep, voffB);
            PG8_WAIT_V(6); PG8_BAR; PG8_MMA(1, 1, At, B1); PG8_BAR;
        }
        E(acc, cur, wr, wc, fr, fq);
        if (!has_next) break;
#pragma unroll
        for (int a = 0; a < 2; ++a)
#pragma unroll
            for (int b = 0; b < 2; ++b)
#pragma unroll
                for (int m = 0; m < 4; ++m)
#pragma unroll
                    for (int n = 0; n < 2; ++n) acc[a][b][m][n] = (f32x4){0.f, 0.f, 0.f, 0.f};
        cur = nxt; cA = nA; cB = nB; ++ui;
    }
    PG8_WAIT_V(0);
    if (wr == 0) PG8_BAR;
    PG8_BAR;
#undef PG8_SA
#undef PG8_SB
#undef PG8_STAGE
#undef PG8_LDA
#undef PG8_LDB
#undef PG8_MMA
#undef PG8_WAIT_V
#undef PG8_WAIT_L
#undef PG8_BAR
#undef PG8_SCHED
}

__device__ __forceinline__ u32x4 pack8(f32x4 v0, f32x4 v1) { u32x4 w; w.x = cvt_pk_bf16(v0[0], v0[1]); w.y = cvt_pk_bf16(v0[2], v0[3]); w.z = cvt_pk_bf16(v1[0], v1[1]); w.w = cvt_pk_bf16(v1[2], v1[3]); return w; }
__device__ __forceinline__ f32x4 sig4(f32x4 v) { return (f32x4){sigmoidf_(v[0]), sigmoidf_(v[1]), sigmoidf_(v[2]), sigmoidf_(v[3])}; }
__device__ __forceinline__ f32x4 silu4(f32x4 v) { return (f32x4){siluf_(v[0]), siluf_(v[1]), siluf_(v[2]), siluf_(v[3])}; }

struct EpiG1 {
    unsigned char* ws; bf16_t* gm;
    __device__ __forceinline__ void operator()(const f32x4 (&acc)[2][2][4][2], const Unit& u, int wr, int wc, int fr, int fq) const {
        const int pn = u.pn; const size_t row0 = (size_t)u.pm * BM + wr * 64 + fr; const int lc = wc * 32 + 8 * fq;
        if (pn == 14) {
            float* O = (float*)(ws + WS_KRGT);
            if (lc < 96) {
#pragma unroll
                for (int ai = 0; ai < 2; ++ai)
#pragma unroll
                    for (int m = 0; m < 4; ++m) { float* rp = O + (row0 + ai * HALF + m * 16) * 96 + lc; *(f32x4*)rp = acc[ai][0][m][0]; *(f32x4*)(rp + 4) = acc[ai][0][m][1]; }
            }
            return;
        }
        if (pn >= 19 && pn < 35) {
            bf16_t* O = (bf16_t*)(ws + WS_GMZ) + (pn - 19) * 128 + lc;
#pragma unroll
            for (int ai = 0; ai < 2; ++ai)
#pragma unroll
                for (int m = 0; m < 4; ++m) { const f32x4 a0 = sig4(acc[ai][0][m][0]) * silu4(acc[ai][1][m][0]), a1 = sig4(acc[ai][0][m][1]) * silu4(acc[ai][1][m][1]);
                    __builtin_nontemporal_store(pack8(a0, a1), (u32x4*)(O + (row0 + ai * HALF + m * 16) * 2048)); }
            return;
        }
        bf16_t* O; int ld, act = 0;
        if (pn < 4) { O = (bf16_t*)(ws + WS_KM) + pn * 256; ld = 1024; }
        else if (pn < 12) { O = (bf16_t*)(ws + WS_VM) + (pn - 4) * 256; ld = 2048; }
        else if (pn < 14) { O = (bf16_t*)(ws + WS_CKV) + (pn - 12) * 256; ld = 512; }
        else if (pn < 19) { O = (bf16_t*)(ws + WS_QM) + (pn - 15) * 256; ld = 1024; }
        else if (pn < 47) { O = (bf16_t*)(ws + WS_QA) + (pn - 35) * 256; ld = 3072; }
        else if (pn < 55) { O = (bf16_t*)(ws + WS_ZA) + (pn - 47) * 256; ld = 2048; act = 1; }
        else if (pn < 63) { O = gm + (pn - 55) * 256; ld = 2048; act = 2; }
        else { O = gm + (size_t)NT * 2048 + (pn - 63) * 256; ld = 2048; act = 2; }
        O += lc;
#pragma unroll
        for (int ai = 0; ai < 2; ++ai)
#pragma unroll
            for (int m = 0; m < 4; ++m) { bf16_t* rp = O + (row0 + ai * HALF + m * 16) * ld;
#pragma unroll
                for (int bj = 0; bj < 2; ++bj) { f32x4 v0 = acc[ai][bj][m][0], v1 = acc[ai][bj][m][1];
                    if (act == 1) { v0 = silu4(v0); v1 = silu4(v1); } else if (act == 2) { v0 = sig4(v0); v1 = sig4(v1); }
                    __builtin_nontemporal_store(pack8(v0, v1), (u32x4*)(rp + bj * HALF)); } }
    }
};
struct EpiG2 {
    unsigned char* ws;
    __device__ __forceinline__ void operator()(const f32x4 (&acc)[2][2][4][2], const Unit& u, int wr, int wc, int fr, int fq) const {
        const int pn = u.pn, pm = u.pm; const int lc = wc * 32 + 8 * fq;
        const size_t obase = pm < 64 ? (size_t)(pm >> 4) * SKV + CL + (size_t)(pm & 15) * 256 : (size_t)(pm - 64) * SKV;
        const size_t row0 = obase + wr * 64 + fr;
#pragma unroll
        for (int ai = 0; ai < 2; ++ai)
#pragma unroll
            for (int m = 0; m < 4; ++m) { const size_t r = row0 + ai * HALF + m * 16;
#pragma unroll
                for (int bj = 0; bj < 2; ++bj) {
                    bf16_t* p = pn < 8 ? (bf16_t*)(ws + WS_KB) + r * 3072 + (2 * pn + bj) * 192 + lc : (bf16_t*)(ws + WS_V2) + r * 2048 + (pn - 8) * 256 + bj * HALF + lc;
                    *(u32x4*)p = pack8(acc[ai][bj][m][0], acc[ai][bj][m][1]); } }
    }
};
__device__ __forceinline__ void unpack8(u32x4 w, f32x4& a, f32x4& b) { a = (f32x4){bflo(w.x), bfhi(w.x), bflo(w.y), bfhi(w.y)}; b = (f32x4){bflo(w.z), bfhi(w.z), bflo(w.w), bfhi(w.w)}; }
template <int ADD> struct EpiPM {
    bf16_t* U; const bf16_t* gate;
    __device__ __forceinline__ void operator()(const f32x4 (&acc)[2][2][4][2], const Unit& u, int wr, int wc, int fr, int fq) const {
        const size_t row0 = (size_t)u.pm * BM + wr * 64 + fr; const int col0 = u.pn * BM + wc * 32 + 8 * fq;
#pragma unroll
        for (int ai = 0; ai < 2; ++ai) {
            u32x4 gw[4][2], uw[4][2];
#pragma unroll
            for (int m = 0; m < 4; ++m)
#pragma unroll
                for (int bj = 0; bj < 2; ++bj) { const size_t off = (row0 + ai * HALF + m * 16) * 2048 + col0 + bj * HALF;
                    gw[m][bj] = *(const u32x4*)(gate + off); if (ADD) uw[m][bj] = *(const u32x4*)(U + off); }
#pragma unroll
            for (int m = 0; m < 4; ++m)
#pragma unroll
                for (int bj = 0; bj < 2; ++bj) { const size_t off = (row0 + ai * HALF + m * 16) * 2048 + col0 + bj * HALF;
                    f32x4 g0, g1; unpack8(gw[m][bj], g0, g1);
                    f32x4 v0 = g0 * acc[ai][bj][m][0], v1 = g1 * acc[ai][bj][m][1];
                    if (ADD) { f32x4 p0, p1; unpack8(uw[m][bj], p0, p1); v0 += p0; v1 += p1; }
                    *(u32x4*)(U + off) = pack8(v0, v1); }
        }
    }
};
struct EpiOut {
    const float* x; float* out; const float* gate;
    __device__ __forceinline__ void operator()(const f32x4 (&acc)[2][2][4][2], const Unit& u, int wr, int wc, int fr, int fq) const {
        const size_t row0 = (size_t)u.pm * BM + wr * 64 + fr; const int col0 = u.pn * BM + wc * 32 + 8 * fq; const float* gp = gate + (size_t)(u.pm >> 4) * 6144 + col0;
        f32x4 gv[2][2];
#pragma unroll
        for (int bj = 0; bj < 2; ++bj) { gv[bj][0] = *(const f32x4*)(gp + bj * HALF); gv[bj][1] = *(const f32x4*)(gp + bj * HALF + 4); }
#pragma unroll
        for (int ai = 0; ai < 2; ++ai) {
            f32x4 xv[4][2][2];
#pragma unroll
            for (int m = 0; m < 4; ++m)
#pragma unroll
                for (int bj = 0; bj < 2; ++bj) { const size_t off = (row0 + ai * HALF + m * 16) * 2048 + col0 + bj * HALF; xv[m][bj][0] = *(const f32x4*)(x + off); xv[m][bj][1] = *(const f32x4*)(x + off + 4); }
#pragma unroll
            for (int m = 0; m < 4; ++m)
#pragma unroll
                for (int bj = 0; bj < 2; ++bj) { const size_t off = (row0 + ai * HALF + m * 16) * 2048 + col0 + bj * HALF;
                    *(f32x4*)(out + off) = xv[m][bj][0] + gv[bj][0] * acc[ai][bj][m][0]; *(f32x4*)(out + off + 4) = xv[m][bj][1] + gv[bj][1] * acc[ai][bj][m][1]; }
        }
    }
};
}
__device__ __forceinline__ int win_src(int nq) {
    const int pn = nq >> 3, r = (nq & 7) * 32;
    if (pn < 4) return pn * 256 + r;
    if (pn < 12) return 1024 + (pn - 4) * 256 + r;
    if (pn < 14) return 3104 + (pn - 12) * 256 + r;
    if (pn == 14) return r < 64 ? 3616 + r : (r == 64 ? 3072 : -1);
    if (pn < 19) return 3680 + (pn - 15) * 256 + r;
    if (pn < 35) { const int j0 = (pn - 19) * 128; return r < 128 ? 4704 + j0 + r : 6752 + j0 + (r - 128); }
    if (pn < 47) return 8800 + (pn - 35) * 256 + r;
    if (pn < 55) return 11872 + (pn - 47) * 256 + r;
    return 13920 + (pn - 55) * 256 + r;
}
__device__ __forceinline__ void tr_addr(const Params& p, int t, const float*& q  , bf16_t*& dstp  ) {
    constexpr int T_WIN = 284 * 32, T_UKV = 64 * 8;
    const int tid = threadIdx.x, kk = tid >> 3, jg = (tid & 7) * 8, hi32 = jg >> 5, n = tid >> 3, kg = (tid & 7) * 8;
    if (t < T_WIN) { const int nt = t % 284, kt = t / 284; const int c = win_src(nt * 2 + hi32);
        q = c >= 0 ? p.w_in + (size_t)(kt * 64 + kk) * IN_COLS + c + (jg & 31) : nullptr;
        dstp = (bf16_t*)(p.ws + WS_WIN) + (size_t)(nt * 64 + n) * LDH + kt * 64 + kg; }
    else if (t < T_WIN + T_UKV) { const int u = t - T_WIN, nt = u >> 3, kt = u & 7;
        q = (nt < 32 ? p.w_uk + nt * 64 : p.w_uv + (nt - 32) * 64) + (size_t)(kt * 64 + kk) * 2048 + jg;
        dstp = (bf16_t*)(p.ws + WS_WUKV) + (size_t)(nt * 64 + n) * 512 + kt * 64 + kg; }
    else { const int u = t - T_WIN - T_UKV, which = u >> 10, nt = (u >> 5) & 31, kt = u & 31;
        q = (which == 0 ? p.w_proj_m : which == 1 ? p.w_proj_a : p.w_out) + (size_t)(kt * 64 + kk) * 2048 + nt * 64 + jg;
        dstp = (bf16_t*)(p.ws + (which == 0 ? WS_WPM : which == 1 ? WS_WPA : WS_WOUT)) + (size_t)(nt * 64 + n) * 2048 + kt * 64 + kg; }
}
__device__ __forceinline__ void tr_load(const float* q, f32x4& a, f32x4& b) {
    a = (f32x4){0.f, 0.f, 0.f, 0.f}; b = a;
    if (q) { a = *(const f32x4*)q; b = *(const f32x4*)(q + 4); }
}
__device__ __forceinline__ void tr_store(float* tile  , bf16_t* dstp, const f32x4 a, const f32x4 b) {
    const int tid = threadIdx.x;
    { const int kk = tid >> 3, jg = (tid & 7) * 8; float* t = tile + kk * 65 + jg; t[0] = a[0]; t[1] = a[1]; t[2] = a[2]; t[3] = a[3]; t[4] = b[0]; t[5] = b[1]; t[6] = b[2]; t[7] = b[3]; }
    __syncthreads();
    { const int n = tid >> 3, kg = (tid & 7) * 8; const float* t = tile + kg * 65 + n;
      u32x4 w; w.x = cvt_pk_bf16(t[0], t[65]); w.y = cvt_pk_bf16(t[130], t[195]); w.z = cvt_pk_bf16(t[260], t[325]); w.w = cvt_pk_bf16(t[390], t[455]);
      *(u32x4*)dstp = w; }
    __syncthreads();
}
__device__ void phase_prep(const Params& p, unsigned char* smem) {
    const int tid = threadIdx.x, G = gridDim.x, bid = blockIdx.x;
    float* sm = (float*)smem;
    if (bid < 256) {
        float* sv = sm;
        float* red = sm + 5 * 2048;
        for (int i = tid; i < 5 * 2048; i += NTHR) { const int v = i >> 11, k = i & 2047; const float cv = v < 4 ? p.c[v * 2048 + k] : p.c_ctx[k]; sv[i] = siluf_(cv); }
        __syncthreads();
        for (int cgp = bid; cgp < 256; cgp += G) {
            const int col = tid % 24, kg = tid / 24;
            if (kg < 21) { float a0 = 0, a1 = 0, a2 = 0, a3 = 0, a4 = 0; const float* w = p.ada_w + cgp * 24 + col;
                for (int k0 = kg; k0 < 2048; k0 += 21 * 14) {
                    float wv[14];
#pragma unroll
                    for (int u = 0; u < 14; ++u) { const int k = k0 + 21 * u; wv[u] = k < 2048 ? w[(size_t)k * 6144] : 0.f; }
#pragma unroll
                    for (int u = 0; u < 14; ++u) { const int k = k0 + 21 * u; if (k < 2048) { a0 += sv[k] * wv[u]; a1 += sv[2048 + k] * wv[u]; a2 += sv[4096 + k] * wv[u]; a3 += sv[6144 + k] * wv[u]; a4 += sv[8192 + k] * wv[u]; } }
                }
                float* r = red + (kg * 24 + col) * 5; r[0] = a0; r[1] = a1; r[2] = a2; r[3] = a3; r[4] = a4; }
            __syncthreads();
            if (tid < 120) { const int c2 = tid / 5, v = tid % 5; float s = 0; for (int g = 0; g < 21; ++g) s += red[(g * 24 + c2) * 5 + v];
                ((float*)(p.ws + WS_MOD))[v * 6144 + cgp * 24 + c2] = s + p.ada_b[cgp * 24 + c2]; }
            __syncthreads();
        }
    }
    float* tile = sm;
    constexpr int T_ALL = 284 * 32 + 64 * 8 + 3 * 32 * 32;
    const int n = bid < T_ALL ? (T_ALL - bid + G - 1) / G : 0;
    f32x4 A4[4], B4[4]; bf16_t* D4[4];
#pragma unroll
    for (int u = 0; u < 4; ++u) { A4[u] = (f32x4){0.f, 0.f, 0.f, 0.f}; B4[u] = A4[u]; D4[u] = nullptr; if (u < n) { const float* q; tr_addr(p, bid + u * G, q, D4[u]); tr_load(q, A4[u], B4[u]); } }
    for (int k0 = 0; k0 < n; k0 += 4) {
#pragma unroll
        for (int u = 0; u < 4; ++u) { const int k = k0 + u;
            if (k < n) { tr_store(tile, D4[u], A4[u], B4[u]);
                if (k + 4 < n) { const float* q; tr_addr(p, bid + (k + 4) * G, q, D4[u]); tr_load(q, A4[u], B4[u]); } } }
    }
}
__device__ void phase_hrows(const Params& p, unsigned char* smem) {
    const int tid = threadIdx.x, G = gridDim.x, lane = tid & 63, wid = tid >> 6;
    float* red = (float*)smem;
    const float* MOD = (const float*)(p.ws + WS_MOD);
    const f32x4 g = *(const f32x4*)(p.norm_g + tid * 4);
    int it = 0, vcur = -1; f32x4 sh = (f32x4){0.f, 0.f, 0.f, 0.f}, sc = sh;
    auto rowptr = [&](int r) { return (r < NT ? p.x + (size_t)r * 2048 : p.ctx + (size_t)(r - NT) * 2048) + tid * 4; };
    f32x4 xq[4];
#pragma unroll
    for (int u = 0; u < 4; ++u) { const int r = blockIdx.x + u * G; xq[u] = (f32x4){0.f, 0.f, 0.f, 0.f}; if (r < NR) xq[u] = *(const f32x4*)rowptr(r); }
    for (int row0 = blockIdx.x; row0 < NR; row0 += 4 * G)
#pragma unroll
    for (int u = 0; u < 4; ++u) { const int row = row0 + u * G; if (row < NR) { ++it;
        const int v = row < NT ? row >> 12 : 4;
        const f32x4 xv = xq[u];
        { const int rn = row + 4 * G; if (rn < NR) xq[u] = *(const f32x4*)rowptr(rn); }
        float ss = xv[0] * xv[0] + xv[1] * xv[1] + xv[2] * xv[2] + xv[3] * xv[3];
        ss = wave_sum(ss);
        float* r = red + (it & 1) * 8;
        if (lane == 0) r[wid] = ss;
        __syncthreads();
        float tot = 0;
#pragma unroll
        for (int i = 0; i < 8; ++i) tot += r[i];
        const float rstd = rsqrtf(tot * (1.0f / 2048.0f) + EPS);
        if (v != vcur) { sh = *(const f32x4*)(MOD + v * 6144 + tid * 4); sc = *(const f32x4*)(MOD + v * 6144 + 2048 + tid * 4); vcur = v; }
        const f32x4 y = xv * rstd * g * (sc + 1.0f) + sh;
        u32x2 w; w.x = cvt_pk_bf16(y[0], y[1]); w.y = cvt_pk_bf16(y[2], y[3]);
        *(u32x2*)((bf16_t*)(p.ws + WS_H) + (size_t)row * LDH + tid * 4) = w;
    } }
    __syncthreads();
}
namespace ml {
constexpr int QS = 136, KTS = 72, CTS = 136;
constexpr int OFF_Q = 0, OFF_K = 17408, OFF_KT = 34816, OFF_VT = 53248, OFF_VWT = 62464, OFF_P = 71680, OFF_CT = 80896, OFF_F = 98304;
constexpr int F_N = 0, F_ROWC = 128, F_AV = 192, F_SINT = 256, F_EINV = 320, F_WS = 384, F_PSUM = 448, F_QN = 576, F_CWQ = 640, F_CWK = 1280, F_CBQ = 1920, F_CBK = 2048;
__device__ __forceinline__ int crow(int r, int hi) { return (r & 3) + 8 * (r >> 2) + 4 * hi; }
__device__ __forceinline__ bf16x8 ldfrag(const unsigned char* base, int row, int stride, int k) { return *(const bf16x8*)(base + ((size_t)row * stride + k) * 2); }


__device__ void phase_conv(const Params& p) {
    const int tid = threadIdx.x, G = gridDim.x;
    constexpr int NKI = (NR / 64) * 8, NQI = (NT / 64) * 8, NI = NKI + NQI;
    const int i = tid >> 3;
    auto load_item = [&](int item, u32x4 (&W)[10]) {
        const bool isq = item >= NKI; const int it = isq ? item - NKI : item; const int h = it & 7, row0 = (it >> 3) * 64;
        const int seq0 = row0 < NT ? (row0 & ~(SEQ - 1)) : NT + ((row0 - NT) & ~(CL - 1)), seqlen = row0 < NT ? SEQ : CL;
        const bf16_t* src = (const bf16_t*)(p.ws + (isq ? WS_QM : WS_KM)); const int t = row0 + i - seq0;
#pragma unroll
        for (int half = 0; half < 2; ++half) { const int d0 = ((tid & 7) + half * 8) * 8;
#pragma unroll
            for (int j = 0; j < 5; ++j) { const int tt = t + j - 2; W[half * 5 + j] = (u32x4){0u, 0u, 0u, 0u};
                if (tt >= 0 && tt < seqlen) W[half * 5 + j] = *(const u32x4*)(src + (size_t)(seq0 + tt) * 1024 + h * 128 + d0); } }
    };
    auto compute_item = [&](int item, const u32x4 (&W)[10]) {
        const bool isq = item >= NKI; const int it = isq ? item - NKI : item; const int h = it & 7, row0 = (it >> 3) * 64;
        bf16_t* dst = (bf16_t*)(p.ws + (isq ? WS_QC : WS_KC));
        const float* cw = p.conv_w + (isq ? 0 : 1024) + h * 128; const float* cb = p.conv_b + (isq ? 0 : 1024) + h * 128;
        const float sc = isq ? 0.08838834764831845f : 1.0f;
        f32x4 cwv[2][6][2];
#pragma unroll
        for (int half = 0; half < 2; ++half) { const int d0 = ((tid & 7) + half * 8) * 8;
#pragma unroll
            for (int j = 0; j < 5; ++j) { cwv[half][j][0] = *(const f32x4*)(cw + j * 2048 + d0); cwv[half][j][1] = *(const f32x4*)(cw + j * 2048 + d0 + 4); }
            cwv[half][5][0] = *(const f32x4*)(cb + d0); cwv[half][5][1] = *(const f32x4*)(cb + d0 + 4); }
#pragma unroll
        for (int half = 0; half < 2; ++half) { const int d0 = ((tid & 7) + half * 8) * 8;
            f32x4 a0 = cwv[half][5][0], a1 = cwv[half][5][1];
#pragma unroll
            for (int j = 0; j < 5; ++j) { const u32x4 w = W[half * 5 + j];
                const f32x4 c0 = cwv[half][j][0], c1 = cwv[half][j][1];
                a0 += c0 * (f32x4){bflo(w.x), bfhi(w.x), bflo(w.y), bfhi(w.y)}; a1 += c1 * (f32x4){bflo(w.z), bfhi(w.z), bflo(w.w), bfhi(w.w)}; }
#pragma unroll
            for (int e = 0; e < 4; ++e) { a0[e] = a0[e] * __builtin_amdgcn_rcpf(1.0f + __expf(-a0[e])) * sc; a1[e] = a1[e] * __builtin_amdgcn_rcpf(1.0f + __expf(-a1[e])) * sc; }
            u32x4 o; o.x = cvt_pk_bf16(a0[0], a0[1]); o.y = cvt_pk_bf16(a0[2], a0[3]); o.z = cvt_pk_bf16(a1[0], a1[1]); o.w = cvt_pk_bf16(a1[2], a1[3]);
            *(u32x4*)(dst + (size_t)(row0 + i) * 1024 + h * 128 + d0) = o; }
    };
    u32x4 Wa[10], Wb[10];
    int item = blockIdx.x;
    if (item < NI) load_item(item, Wa);
    for (; item < NI; item += 2 * G) {
        if (item + G < NI) load_item(item + G, Wb);
        compute_item(item, Wa);
        if (item + G < NI) { if (item + 2 * G < NI) load_item(item + 2 * G, Wa); compute_item(item + G, Wb); }
    }
}

__device__ void phase_mlstm(const Params& p, unsigned char* smem) {
    const int tid = threadIdx.x, G = gridDim.x, lane = tid & 63, wid = __builtin_amdgcn_readfirstlane(tid >> 6), r32 = lane & 31, hi = lane >> 5;
    float* F = (float*)(smem + OFF_F);
    const bf16_t* KC = (const bf16_t*)(p.ws + WS_KC); const bf16_t* VM = (const bf16_t*)(p.ws + WS_VM); const bf16_t* QC = (const bf16_t*)(p.ws + WS_QC);
    const float* KRGT = (const float*)(p.ws + WS_KRGT);
    for (int it0 = blockIdx.x; it0 < 256; it0 += G) {
        const int item = (G == 256) ? (((it0 & 7) + 8 * (it0 >> 6)) << 3) + ((it0 >> 3) & 7) : it0;
        const int sl = item & 3, dir = (item >> 2) & 1, h = (item >> 3) & 7, b = item >> 6;
        bf16_t* HX = (bf16_t*)(p.ws + (dir ? WS_HB : WS_HF));
        if (tid < 128) F[F_N + tid] = 0.f;
        for (int i = tid; i < 64 * CTS / 2; i += NTHR) ((unsigned*)(smem + OFF_CT))[i] = 0u;
        f32x16 Cst; for (int r = 0; r < 16; ++r) Cst[r] = 0.f;
        float m_prev = -1e30f;
        const float gbi = p.gate_b[(2 * dir) * 8 + h], gbf = p.gate_b[(2 * dir + 1) * 8 + h];
        __syncthreads();
        u32x4 pk0, pk1, pq0, pq1, pv; float pgi, pgf;
#define ML_CHUNK(stx, isctx_, tokbase_, rowbase_) const bool isctx_ = (stx) < 4; const int tokbase_ = (isctx_ ? (dir ? 3 - (stx) : (stx)) : (dir ? 67 - (stx) : (stx) - 4)) * 64, rowbase_ = isctx_ ? NT + b * CL : b * SEQ
#define ML_LBAR() do { asm volatile("s_waitcnt lgkmcnt(0)" ::: "memory"); __builtin_amdgcn_s_barrier(); asm volatile("" ::: "memory"); } while (0)
#define ML_LOAD(stx) do { ML_CHUNK(stx, ic_, tb_, rb_); \
            { const int i0 = tid & 31, c0 = (tid >> 5) * 8; const size_t r0 = (size_t)(rb_ + tb_ + (dir ? 63 - i0 : i0)) * 1024 + h * 128 + c0, r1 = (size_t)(rb_ + tb_ + (dir ? 31 - i0 : 32 + i0)) * 1024 + h * 128 + c0; \
              pk0 = *(const u32x4*)(KC + r0); pk1 = *(const u32x4*)(KC + r1); if (!ic_) { pq0 = *(const u32x4*)(QC + r0); pq1 = *(const u32x4*)(QC + r1); } } \
            { const int iv = tid & 63; pv = *(const u32x4*)(VM + (size_t)(rb_ + tb_ + (dir ? 63 - iv : iv)) * 2048 + h * 256 + sl * 64 + (tid >> 6) * 8); } \
            { const float* gp = KRGT + (size_t)(rb_ + tb_ + (dir ? 63 - lane : lane)) * 96 + 64 + h; pgi = gp[(2 * dir) * 8]; pgf = gp[(2 * dir + 1) * 8]; } } while (0)
#define ML_SCAN(bi) do { float* FB_ = F + 640 + (bi) * 384; \
            const float gi = pgi + gbi, gf = pgf + gbf; \
            const float lf = fminf(gf, 0.f) - __logf(1.0f + __expf(-fabsf(gf))); \
            float bc = lf; \
            _Pragma("unroll") for (int o = 1; o < 64; o <<= 1) { const float v_ = __shfl_up(bc, o); if (lane >= o) bc += v_; } \
            const float a_ = gi - bc; float pm = a_; \
            _Pragma("unroll") for (int o = 1; o < 64; o <<= 1) { const float v_ = __shfl_up(pm, o); if (lane >= o) pm = fmaxf(pm, v_); } \
            const float btot = __shfl(bc, 63); \
            const float mrow = bc + fmaxf(m_prev, pm); \
            const float wsraw = btot + a_; const float wmax = wave_max(wsraw); \
            const float m_new = fmaxf(btot + m_prev, wmax); \
            FB_[lane] = bc - mrow; FB_[64 + lane] = a_; FB_[128 + lane] = __expf(bc + m_prev - mrow); FB_[192 + lane] = __expf(-mrow); { const float wsv_ = __expf(wsraw - m_new); FB_[256 + lane] = wsv_; ((bf16_t*)(FB_ + 324))[lane] = (bf16_t)(cvt_pk_bf16(wsv_, 0.f) & 0xffff); } \
            if (lane == 0) FB_[320] = __expf(btot + m_prev - m_new); \
            m_prev = m_new; } while (0)
        ML_LOAD(0);
        if (wid == 3) ML_SCAN(0);
        __syncthreads();
        for (int st = 0; st < 68; ++st) {
            ML_CHUNK(st, isctx, tokbase, rowbase);
            const float* FBc = F + 640 + (st & 1) * 384; const float decay = FBc[320];
            {
                const int i0 = tid & 31, c0 = (tid >> 5) * 8;
                *(u32x4*)(smem + OFF_K + (i0 * QS + c0) * 2) = pk0; *(u32x4*)(smem + OFF_K + ((32 + i0) * QS + c0) * 2) = pk1;
                bf16_t* kt = (bf16_t*)(smem + OFF_KT) + c0 * KTS + i0;
                kt[0] = (bf16_t)(pk0.x & 0xffff); kt[KTS] = (bf16_t)(pk0.x >> 16); kt[2 * KTS] = (bf16_t)(pk0.y & 0xffff); kt[3 * KTS] = (bf16_t)(pk0.y >> 16);
                kt[4 * KTS] = (bf16_t)(pk0.z & 0xffff); kt[5 * KTS] = (bf16_t)(pk0.z >> 16); kt[6 * KTS] = (bf16_t)(pk0.w & 0xffff); kt[7 * KTS] = (bf16_t)(pk0.w >> 16);
                kt += 32;
                kt[0] = (bf16_t)(pk1.x & 0xffff); kt[KTS] = (bf16_t)(pk1.x >> 16); kt[2 * KTS] = (bf16_t)(pk1.y & 0xffff); kt[3 * KTS] = (bf16_t)(pk1.y >> 16);
                kt[4 * KTS] = (bf16_t)(pk1.z & 0xffff); kt[5 * KTS] = (bf16_t)(pk1.z >> 16); kt[6 * KTS] = (bf16_t)(pk1.w & 0xffff); kt[7 * KTS] = (bf16_t)(pk1.w >> 16);
                if (!isctx) { *(u32x4*)(smem + OFF_Q + (i0 * QS + c0) * 2) = pq0; *(u32x4*)(smem + OFF_Q + ((32 + i0) * QS + c0) * 2) = pq1; }
                const int i = tid & 63, cg8 = (tid >> 6) * 8; const float wsi = FBc[256 + i];
                const float vv[8] = {bflo(pv.x), bfhi(pv.x), bflo(pv.y), bfhi(pv.y), bflo(pv.z), bfhi(pv.z), bflo(pv.w), bfhi(pv.w)};
                bf16_t* vt = (bf16_t*)(smem + OFF_VT) + cg8 * KTS + i; bf16_t* vwt = (bf16_t*)(smem + OFF_VWT) + cg8 * KTS + i;
                vt[0] = (bf16_t)(pv.x & 0xffff); vt[KTS] = (bf16_t)(pv.x >> 16); vt[2 * KTS] = (bf16_t)(pv.y & 0xffff); vt[3 * KTS] = (bf16_t)(pv.y >> 16);
                vt[4 * KTS] = (bf16_t)(pv.z & 0xffff); vt[5 * KTS] = (bf16_t)(pv.z >> 16); vt[6 * KTS] = (bf16_t)(pv.w & 0xffff); vt[7 * KTS] = (bf16_t)(pv.w >> 16);
#pragma unroll
                for (int e = 0; e < 8; e += 2) { const unsigned pw = cvt_pk_bf16(vv[e] * wsi, vv[e + 1] * wsi); vwt[e * KTS] = (bf16_t)(pw & 0xffff); vwt[(e + 1) * KTS] = (bf16_t)(pw >> 16); }
            }
            if (st + 1 < 68) ML_LOAD(st + 1);
            ML_LBAR();
            f32x16 accQC; for (int r = 0; r < 16; ++r) accQC[r] = 0.f;
            if (!isctx) {
                { const int i = tid >> 3, part = tid & 7; const u32x4 q0 = *(const u32x4*)(smem + OFF_Q + (i * QS + part * 16) * 2), q1 = *(const u32x4*)(smem + OFF_Q + (i * QS + part * 16 + 8) * 2);
                  const float* nn = F + F_N + part * 16;
                  float s = bflo(q0.x) * nn[0] + bfhi(q0.x) * nn[1] + bflo(q0.y) * nn[2] + bfhi(q0.y) * nn[3] + bflo(q0.z) * nn[4] + bfhi(q0.z) * nn[5] + bflo(q0.w) * nn[6] + bfhi(q0.w) * nn[7]
                          + bflo(q1.x) * nn[8] + bfhi(q1.x) * nn[9] + bflo(q1.y) * nn[10] + bfhi(q1.y) * nn[11] + bflo(q1.z) * nn[12] + bfhi(q1.z) * nn[13] + bflo(q1.w) * nn[14] + bfhi(q1.w) * nn[15];
                  s += __shfl_xor(s, 1); s += __shfl_xor(s, 2); s += __shfl_xor(s, 4);
                  if (part == 0) F[F_QN + i] = s; }
                if (wid < 4) {
                    const int stile = wid & 1, ttile = wid >> 1; const int t = 32 * ttile + r32;
                    f32x16 acc; for (int r = 0; r < 16; ++r) acc[r] = 0.f;
                    float vals[16]; float psum = 0.f;
                    if (!(stile == 1 && ttile == 0)) {
#pragma unroll 2
                        for (int kk = 0; kk < 8; ++kk) acc = __builtin_amdgcn_mfma_f32_32x32x16_bf16(ldfrag(smem + OFF_K, 32 * stile + r32, QS, kk * 16 + hi * 8), ldfrag(smem + OFF_Q, t, QS, kk * 16 + hi * 8), acc, 0, 0, 0);
                        const float rc = FBc[t];
#pragma unroll
                        for (int r = 0; r < 16; ++r) { const int s = 32 * stile + crow(r, hi); const float e = __expf(fminf(rc + FBc[64 + s], 0.f)); vals[r] = s <= t ? acc[r] * e : 0.f; psum += vals[r]; }
                    } else {
#pragma unroll
                        for (int r = 0; r < 16; ++r) vals[r] = 0.f;
                    }
                    psum += __shfl_xor(psum, 32);
                    if (hi == 0) F[F_PSUM + stile * 64 + t] = psum;
#pragma unroll
                    for (int g4 = 0; g4 < 4; ++g4) { u32x2 w; w.x = cvt_pk_bf16(vals[4 * g4], vals[4 * g4 + 1]); w.y = cvt_pk_bf16(vals[4 * g4 + 2], vals[4 * g4 + 3]);
                        *(u32x2*)(smem + OFF_P + (t * KTS + 32 * stile + 8 * g4 + 4 * hi) * 2) = w; }
                } else {
                    const int w4 = wid - 4, ttile = w4 & 1, ctile = w4 >> 1;
#pragma unroll 2
                    for (int kk = 0; kk < 8; ++kk) accQC = __builtin_amdgcn_mfma_f32_32x32x16_bf16(ldfrag(smem + OFF_Q, 32 * ttile + r32, QS, kk * 16 + hi * 8), ldfrag(smem + OFF_CT, 32 * ctile + r32, CTS, kk * 16 + hi * 8), accQC, 0, 0, 0);
                }
            }
            ML_LBAR();
            if (!isctx && wid >= 4) {
                const int w4 = wid - 4, ttile = w4 & 1, ctile = w4 >> 1;
                f32x16 accPV; for (int r = 0; r < 16; ++r) accPV[r] = 0.f;
#pragma unroll
                for (int kk = 0; kk < 4; ++kk) accPV = __builtin_amdgcn_mfma_f32_32x32x16_bf16(ldfrag(smem + OFF_P, 32 * ttile + r32, KTS, kk * 16 + hi * 8), ldfrag(smem + OFF_VT, 32 * ctile + r32, KTS, kk * 16 + hi * 8), accPV, 0, 0, 0);
                const int c = 32 * ctile + r32;
                float inv[16], sig[16];
#pragma unroll
                for (int r = 0; r < 16; ++r) { const int t = 32 * ttile + crow(r, hi); const float si = FBc[128 + t];
                    const float den = F[F_PSUM + t] + F[F_PSUM + 64 + t] + si * F[F_QN + t];
                    inv[r] = __builtin_amdgcn_rcpf(fmaxf(fabsf(den), FBc[192 + t])); sig[r] = si; }
#pragma unroll
                for (int r = 0; r < 16; ++r) { const int t = 32 * ttile + crow(r, hi); const float hv = (accPV[r] + sig[r] * accQC[r]) * inv[r];
                    const int tok = tokbase + (dir ? 63 - t : t);
                    HX[(size_t)(b * SEQ + tok) * 2048 + h * 256 + sl * 64 + c] = (bf16_t)(cvt_pk_bf16(hv, 0.f) & 0xffff); }
            }
            {
                const int dtile = wid & 3, ctile = wid >> 2;
#pragma unroll
                for (int r = 0; r < 16; ++r) Cst[r] *= decay;
#pragma unroll
                for (int kk = 0; kk < 4; ++kk) Cst = __builtin_amdgcn_mfma_f32_32x32x16_bf16(ldfrag(smem + OFF_KT, 32 * dtile + r32, KTS, kk * 16 + hi * 8), ldfrag(smem + OFF_VWT, 32 * ctile + r32, KTS, kk * 16 + hi * 8), Cst, 0, 0, 0);
#pragma unroll
                for (int g4 = 0; g4 < 4; ++g4) { u32x2 w; w.x = cvt_pk_bf16(Cst[4 * g4], Cst[4 * g4 + 1]); w.y = cvt_pk_bf16(Cst[4 * g4 + 2], Cst[4 * g4 + 3]);
                    *(u32x2*)(smem + OFF_CT + ((32 * ctile + r32) * CTS + 32 * dtile + 8 * g4 + 4 * hi) * 2) = w; }
            }
            if (wid < 4) {
                f32x16 accN; for (int r = 0; r < 16; ++r) accN[r] = 0.f;
                const bf16_t* wsb = (const bf16_t*)(FBc + 324);
#pragma unroll
                for (int kk = 0; kk < 4; ++kk) { bf16x8 af = *(const bf16x8*)(wsb + kk * 16 + hi * 8); if (r32 != 0) af = (bf16x8){0, 0, 0, 0, 0, 0, 0, 0};
                    accN = __builtin_amdgcn_mfma_f32_32x32x16_bf16(af, ldfrag(smem + OFF_KT, 32 * wid + r32, KTS, kk * 16 + hi * 8), accN, 0, 0, 0); }
                if (hi == 0) F[F_N + 32 * wid + r32] = decay * F[F_N + 32 * wid + r32] + accN[0];
            }
            if (wid == 3 && st + 1 < 68) ML_SCAN((st + 1) & 1);
            ML_LBAR();
        }
    }
}
}
__device__ __forceinline__ void rope_pair(float& val, int i  , int tpos) {
    const int ax = i >> 5, half = (i >> 4) & 1, f = i & 15;
    const float partner = __shfl_xor(val, 16);
    const float pos = (float)(ax == 0 ? (tpos >> 6) : (tpos & 63));
    const float freq = exp2f(-(float)f * (13.287712379549449f / 16.0f));
    const float ang = pos * freq, rev = ang * 0.15915494309189535f;
    const float sn = __builtin_amdgcn_sinf(rev), cs = __builtin_amdgcn_cosf(rev);
    const float x1 = half ? partner : val, x2 = half ? val : partner;
    val = half ? (x1 * sn + x2 * cs) : (x1 * cs - x2 * sn);
}

__device__ __forceinline__ void rope8(float (&v)[8], int sub, int tpos, bool apply) {
    const int ax = (sub >> 2) & 1, half = (sub >> 1) & 1; const float pos = (float)(ax == 0 ? (tpos >> 6) : (tpos & 63));
#pragma unroll
    for (int e = 0; e < 8; ++e) {
        const float partner = __shfl_xor(v[e], 2);
        const float freq = exp2f(-(float)((sub & 1) * 8 + e) * (13.287712379549449f / 16.0f));
        const float rev = pos * freq * 0.15915494309189535f;
        const float sn = __builtin_amdgcn_sinf(rev), cs = __builtin_amdgcn_cosf(rev);
        const float x1 = half ? partner : v[e], x2 = half ? v[e] : partner;
        const float r = half ? (x1 * sn + x2 * cs) : (x1 * cs - x2 * sn);
        if (apply && sub >= 16) v[e] = r;
    }
}
__device__ __forceinline__ float half_sum(float v) { for (int o = 16; o >= 1; o >>= 1) v += __shfl_xor(v, o); return v; }
__device__ void phase_elem(const Params& p) {
    const int tid = threadIdx.x, G = gridDim.x, lane = tid & 63, wid = tid >> 6;
    {
        const bf16_t* HF = (const bf16_t*)(p.ws + WS_HF); const bf16_t* HB = (const bf16_t*)(p.ws + WS_HB); bf16_t* GZ = (bf16_t*)(p.ws + WS_GMZ);
        const f32x4 g = *(const f32x4*)(p.mh_norm_g + tid * 4);
        for (int row0 = blockIdx.x; row0 < NT; row0 += 4 * G) {
            u32x2 av[4], bv[4], zv[4];
#pragma unroll
            for (int u = 0; u < 4; ++u) { const int row = row0 + u * G; if (row < NT) { const size_t off = (size_t)row * 2048 + tid * 4; av[u] = *(const u32x2*)(HF + off); bv[u] = *(const u32x2*)(HB + off); zv[u] = *(const u32x2*)(GZ + off); } }
#pragma unroll
            for (int u = 0; u < 4; ++u) { const int row = row0 + u * G; if (row < NT) { const size_t off = (size_t)row * 2048 + tid * 4; const u32x2 a = av[u], b = bv[u], z = zv[u];
                const f32x4 s = (f32x4){bflo(a.x) + bflo(b.x), bfhi(a.x) + bfhi(b.x), bflo(a.y) + bflo(b.y), bfhi(a.y) + bfhi(b.y)};
                const float ss = wave_sum(s[0] * s[0] + s[1] * s[1] + s[2] * s[2] + s[3] * s[3]);
                const float rstd = rsqrtf(ss * (1.0f / 256.0f) + EPS);
                const f32x4 y = s * rstd * g * (f32x4){bflo(z.x), bfhi(z.x), bflo(z.y), bfhi(z.y)};
                u32x2 w; w.x = cvt_pk_bf16(y[0], y[1]); w.y = cvt_pk_bf16(y[2], y[3]);
                *(u32x2*)(GZ + off) = w; } }
        }
    }
    {
        bf16_t* QA = (bf16_t*)(p.ws + WS_QA); const int sub = lane & 31, subc = sub < 24 ? sub : 23;
        const f32x4 ga = *(const f32x4*)(p.q_norm_g + subc * 8), gb = *(const f32x4*)(p.q_norm_g + subc * 8 + 4);
        for (int it0 = (blockIdx.x * 8 + wid) * 2 + (lane >> 5); it0 < NT * 16; it0 += 4 * G * 16) {
            u32x4 wv[4];
#pragma unroll
            for (int u = 0; u < 4; ++u) { const int it = it0 + u * G * 16; if (it < NT * 16) wv[u] = *(const u32x4*)(QA + (size_t)(it >> 4) * 3072 + (it & 15) * 192 + subc * 8); }
#pragma unroll
            for (int u = 0; u < 4; ++u) { const int it = it0 + u * G * 16; if (it < NT * 16) {
                const int row = it >> 4, hd = it & 15; u32x4* qp = (u32x4*)(QA + (size_t)row * 3072 + hd * 192 + subc * 8);
                const u32x4 w = wv[u];
                float v[8] = {bflo(w.x), bfhi(w.x), bflo(w.y), bfhi(w.y), bflo(w.z), bfhi(w.z), bflo(w.w), bfhi(w.w)};
                float ss = 0.f;
#pragma unroll
                for (int e2 = 0; e2 < 8; ++e2) ss += v[e2] * v[e2];
                const float rstd = rsqrtf(half_sum(sub < 24 ? ss : 0.f) * (1.0f / 192.0f) + EPS);
#pragma unroll
                for (int e2 = 0; e2 < 4; ++e2) { v[e2] *= rstd * ga[e2]; v[4 + e2] *= rstd * gb[e2]; }
                rope8(v, sub, row & 4095, true);
#pragma unroll
                for (int e2 = 0; e2 < 8; ++e2) v[e2] *= 0.10411754627145016f;
                u32x4 o; o.x = cvt_pk_bf16(v[0], v[1]); o.y = cvt_pk_bf16(v[2], v[3]); o.z = cvt_pk_bf16(v[4], v[5]); o.w = cvt_pk_bf16(v[6], v[7]);
                if (sub < 24) *qp = o; } }
        }
    }
    {
        bf16_t* CK = (bf16_t*)(p.ws + WS_CKV);
        const f32x4 ga = *(const f32x4*)(p.kv_norm_g + lane * 8), gb = *(const f32x4*)(p.kv_norm_g + lane * 8 + 4);
        for (int row0 = blockIdx.x * 8 + wid; row0 < NR; row0 += 4 * G * 8) {
            u32x4 wv[4];
#pragma unroll
            for (int u = 0; u < 4; ++u) { const int row = row0 + u * G * 8; if (row < NR) wv[u] = *(const u32x4*)(CK + (size_t)row * 512 + lane * 8); }
#pragma unroll
            for (int u = 0; u < 4; ++u) { const int row = row0 + u * G * 8; if (row < NR) {
                u32x4* pp = (u32x4*)(CK + (size_t)row * 512 + lane * 8); const u32x4 w = wv[u];
                f32x4 a = (f32x4){bflo(w.x), bfhi(w.x), bflo(w.y), bfhi(w.y)}, b = (f32x4){bflo(w.z), bfhi(w.z), bflo(w.w), bfhi(w.w)};
                const float rstd = rsqrtf(wave_sum(a[0] * a[0] + a[1] * a[1] + a[2] * a[2] + a[3] * a[3] + b[0] * b[0] + b[1] * b[1] + b[2] * b[2] + b[3] * b[3]) * (1.0f / 512.0f) + EPS);
                a = a * rstd * ga; b = b * rstd * gb;
                u32x4 o; o.x = cvt_pk_bf16(a[0], a[1]); o.y = cvt_pk_bf16(a[2], a[3]); o.z = cvt_pk_bf16(b[0], b[1]); o.w = cvt_pk_bf16(b[2], b[3]);
                *pp = o; } }
        }
    }
}
__device__ void phase_kfin(const Params& p) {
    const int tid = threadIdx.x, G = gridDim.x, lane = tid & 63, wid = tid >> 6;
    bf16_t* KB = (bf16_t*)(p.ws + WS_KB); const float* KRGT = (const float*)(p.ws + WS_KRGT);
    const int sub = lane & 31, subc = sub < 24 ? sub : 23;
    const f32x4 ga = *(const f32x4*)(p.k_norm_g + subc * 8), gb = *(const f32x4*)(p.k_norm_g + subc * 8 + 4);
    for (int it0 = (blockIdx.x * 8 + wid) * 2 + (lane >> 5); it0 < NR * 16; it0 += 8 * G * 16) {
        f32x4 la[8], lb[8];
#pragma unroll
        for (int u = 0; u < 8; ++u) lb[u] = (f32x4){0.f, 0.f, 0.f, 0.f};
#pragma unroll
        for (int u = 0; u < 8; ++u) { const int it = it0 + u * G * 16; if (it < NR * 16) {
            const int orow = it >> 4, hd = it & 15; const int b = orow / SKV, j = orow - b * SKV; const int grow = j < CL ? NT + b * CL + j : b * SEQ + (j - CL);
            if (sub < 16) { const u32x4 w = *(const u32x4*)(KB + (size_t)orow * 3072 + hd * 192 + subc * 8); la[u] = __builtin_bit_cast(f32x4, w); }
            else { const float* kr = KRGT + (size_t)grow * 96 + (subc - 16) * 8; la[u] = *(const f32x4*)kr; lb[u] = *(const f32x4*)(kr + 4); } } }
#pragma unroll
        for (int u = 0; u < 8; ++u) { const int it = it0 + u * G * 16; if (it < NR * 16) {
            const int orow = it >> 4, hd = it & 15; const int b = orow / SKV, j = orow - b * SKV; const bool isctx = j < CL;
            u32x4* kp = (u32x4*)(KB + (size_t)orow * 3072 + hd * 192 + subc * 8);
            float v[8] = {la[u][0], la[u][1], la[u][2], la[u][3], lb[u][0], lb[u][1], lb[u][2], lb[u][3]};
            if (sub < 16) { const u32x4 w = __builtin_bit_cast(u32x4, la[u]); v[0] = bflo(w.x); v[1] = bfhi(w.x); v[2] = bflo(w.y); v[3] = bfhi(w.y); v[4] = bflo(w.z); v[5] = bfhi(w.z); v[6] = bflo(w.w); v[7] = bfhi(w.w); }
            float ss = 0.f;
#pragma unroll
            for (int e2 = 0; e2 < 8; ++e2) ss += v[e2] * v[e2];
            const float rstd = rsqrtf(half_sum(sub < 24 ? ss : 0.f) * (1.0f / 192.0f) + EPS);
#pragma unroll
            for (int e2 = 0; e2 < 4; ++e2) { v[e2] *= rstd * ga[e2]; v[4 + e2] *= rstd * gb[e2]; }
            rope8(v, sub, j - CL, !isctx);
            u32x4 o; o.x = cvt_pk_bf16(v[0], v[1]); o.y = cvt_pk_bf16(v[2], v[3]); o.z = cvt_pk_bf16(v[4], v[5]); o.w = cvt_pk_bf16(v[6], v[7]);
            if (sub < 24) *kp = o; } }
    }
}
namespace att {
constexpr int DQ = 192, NW = 8, QBLK = 32, KVBLK = 64;
constexpr float SCALE = 0.07216878364870322f;
constexpr float THR = 8.f;
constexpr int LDQ = 3072, LDK = 3072, LDV = 2048, LDO = 2048;
constexpr int SDEPTH = 1;
constexpr int SHM_V = KVBLK * 128 * 2, SHM_K = KVBLK * DQ * 2, SHM_ATTN = 3 * SHM_V + 3 * SHM_K + NW * 64 * 4;
#define KSWZ(row, colB) ((row) * 384 + ((colB) ^ (((row) & 7) << 4)))
#define SBAR() __builtin_amdgcn_sched_barrier(0)
__device__ __forceinline__ int crow(int r, int hi) { return (r & 3) + 8 * (r >> 2) + 4 * hi; }
__device__ __forceinline__ void softmaxP(f32x16& p0, f32x16& p1, float& l_reg, bf16x8& pa0, bf16x8& pa1, bf16x8& pa2, bf16x8& pa3) {
  for (int r = 0; r < 16; ++r) p0[r] = __builtin_amdgcn_exp2f(p0[r]);
  for (int r = 0; r < 16; ++r) p1[r] = __builtin_amdgcn_exp2f(p1[r]);
  float ps = 0; for (int r = 0; r < 16; ++r) ps += p0[r]; for (int r = 0; r < 16; ++r) ps += p1[r];
  { auto rr = __builtin_amdgcn_permlane32_swap(__float_as_uint(ps), __float_as_uint(ps), false, false);
    ps = __uint_as_float(rr[0]) + __uint_as_float(rr[1]); }
  l_reg += ps;
#define PK4(P, BASE, OUT) do { unsigned a0 = cvt_pk_bf16(P[BASE + 0], P[BASE + 1]), a1 = cvt_pk_bf16(P[BASE + 2], P[BASE + 3]);   \
    unsigned b0 = cvt_pk_bf16(P[BASE + 4], P[BASE + 5]), b1 = cvt_pk_bf16(P[BASE + 6], P[BASE + 7]);                              \
    auto r0 = __builtin_amdgcn_permlane32_swap(a0, b0, false, false); auto r1 = __builtin_amdgcn_permlane32_swap(a1, b1, false, false); \
    u32x4 w = {r0[0], r1[0], r0[1], r1[1]}; OUT = *reinterpret_cast<bf16x8*>(&w); } while (0)
  PK4(p0, 0, pa0); PK4(p0, 8, pa1); PK4(p1, 0, pa2); PK4(p1, 8, pa3);
#undef PK4
}
__device__ __forceinline__ void qkt(f32x16& p0, f32x16& p1, const char* Ks, const bf16x8* qr, const char* qrl, int r32, int hi) {
  for (int r = 0; r < 16; ++r) { p0[r] = 0.f; p1[r] = 0.f; }
#pragma unroll
  for (int d0 = 0; d0 < 12; ++d0) { int cb = (d0 * 16 + hi * 8) * 2;
    bf16x8 b0 = *reinterpret_cast<const bf16x8*>(Ks + KSWZ(r32, cb));
    bf16x8 b1 = *reinterpret_cast<const bf16x8*>(Ks + KSWZ(32 + r32, cb));
    const bf16x8 qf = d0 < 10 ? qr[d0] : *reinterpret_cast<const bf16x8*>(qrl + (d0 - 10) * 1024);
    p0 = __builtin_amdgcn_mfma_f32_32x32x16_bf16(b0, qf, p0, 0, 0, 0);
    p1 = __builtin_amdgcn_mfma_f32_32x32x16_bf16(b1, qf, p1, 0, 0, 0); }
}
__device__ __forceinline__ int v_st(int k, int c) { const int kk = (k & ~0xC) | ((k & 4) << 1) | ((k & 8) >> 1); return ((kk >> 3) * 4 + (c >> 5)) * 512 + ((kk & 7) * 32 + (c & 31)) * 2; }
__device__ __forceinline__ int v_rd_base(int lane) { return ((lane & 3) << 3) | (((lane >> 2) & 3) << 6) | (((lane >> 4) & 1) << 5) | (((lane >> 5) & 1) << 8); }
constexpr int v_rd_off(int d0, int ks, int half) { return d0 * 512 + ks * 4096 + half * 2048; }
template <int OFF> __device__ __forceinline__ s16x4 tr_read(int vb) {
  s16x4 r; asm volatile("ds_read_b64_tr_b16 %0, %1 offset:%2" : "=&v"(r) : "v"(vb), "i"(OFF) : "memory"); return r;
}
template <int D0> __device__ __forceinline__ void pv_one(f32x16& od, int vb, bf16x8 pa0, bf16x8 pa1, bf16x8 pa2, bf16x8 pa3) {
  const s16x4 l0 = tr_read<v_rd_off(D0, 0, 0)>(vb), h0 = tr_read<v_rd_off(D0, 0, 1)>(vb), l1 = tr_read<v_rd_off(D0, 1, 0)>(vb), h1 = tr_read<v_rd_off(D0, 1, 1)>(vb);
  const s16x4 l2 = tr_read<v_rd_off(D0, 2, 0)>(vb), h2 = tr_read<v_rd_off(D0, 2, 1)>(vb), l3 = tr_read<v_rd_off(D0, 3, 0)>(vb), h3 = tr_read<v_rd_off(D0, 3, 1)>(vb);
  asm volatile("s_waitcnt lgkmcnt(0)" ::: "memory"); SBAR();
#define PK(L, H) (bf16x8){L[0], L[1], L[2], L[3], H[0], H[1], H[2], H[3]}
  od = __builtin_amdgcn_mfma_f32_32x32x16_bf16(pa0, PK(l0, h0), od, 0, 0, 0);
  od = __builtin_amdgcn_mfma_f32_32x32x16_bf16(pa1, PK(l1, h1), od, 0, 0, 0);
  od = __builtin_amdgcn_mfma_f32_32x32x16_bf16(pa2, PK(l2, h2), od, 0, 0, 0);
  od = __builtin_amdgcn_mfma_f32_32x32x16_bf16(pa3, PK(l3, h3), od, 0, 0, 0);
#undef PK
}
__device__ __forceinline__ void pv_d0(f32x16* o, int vb, bf16x8 pa0, bf16x8 pa1, bf16x8 pa2, bf16x8 pa3) {
  pv_one<0>(o[0], vb, pa0, pa1, pa2, pa3); pv_one<1>(o[1], vb, pa0, pa1, pa2, pa3); pv_one<2>(o[2], vb, pa0, pa1, pa2, pa3); pv_one<3>(o[3], vb, pa0, pa1, pa2, pa3);
}
__device__ __forceinline__ void attn_body(const bf16_t* __restrict__ Qb, const bf16_t* __restrict__ Kh, const bf16_t* __restrict__ Vh, bf16_t* __restrict__ Ob, int seq, char* lds) {
  const int tid = threadIdx.x, wid = tid >> 6, lane = tid & 63, r32 = lane & 31, hi = lane >> 5;
  char* V_lds = lds; char* K_lds = lds + 3 * SHM_V;
  float* ws = (float*)(lds + 3 * SHM_V + 3 * SHM_K) + wid * 64; float* li_l = ws; float* al_l = ws + 32;
  float l_reg = 0; f32x16 o[4]; for (int d = 0; d < 4; ++d) for (int r = 0; r < 16; ++r) o[d][r] = 0.f;
  bf16x8 qr[10];
  const bf16_t* Qw = Qb + (long)(wid * QBLK + r32) * LDQ + hi * 8;
  char* qrl = lds + SHM_ATTN + wid * 2048 + lane * 16;
#pragma unroll
  for (int d0 = 0; d0 < 10; ++d0) qr[d0] = *reinterpret_cast<const bf16x8*>(Qw + d0 * 16);
#pragma unroll
  for (int d0 = 10; d0 < 12; ++d0) *reinterpret_cast<bf16x8*>(qrl + (d0 - 10) * 1024) = *reinterpret_cast<const bf16x8*>(Qw + d0 * 16);
  const int widu = __builtin_amdgcn_readfirstlane(wid);
  int koff[3], voff[2];
#pragma unroll
  for (int i = 0; i < 3; ++i) { const int u = (widu + 8 * i) * 64 + lane, row = u / 24, x = u % 24, c16 = x ^ (row & 7); koff[i] = row * LDK + c16 * 8; }
#pragma unroll
  for (int i = 0; i < 2; ++i) { const int u = (widu + 8 * i) * 64 + lane, sub = u >> 5, within = u & 31, kk = (sub >> 2) * 8 + (within >> 2), c = (sub & 3) * 32 + (within & 3) * 8;
    const int k = (kk & ~0xC) | ((kk & 4) << 1) | ((kk & 8) >> 1); voff[i] = k * LDV + c; }
  const LAS char* ldsl = (const LAS char*)lds;
  const int vb0 = (int)(uintptr_t)V_lds + v_rd_base(lane);
#define SDMA(b, k0) do { \
    _Pragma("unroll") for (int _i = 0; _i < 3; ++_i) __builtin_amdgcn_global_load_lds((const unsigned*)(Kh + (long)(k0) * LDK + koff[_i]), (LAS unsigned*)(ldsl + 3 * SHM_V + (b) * SHM_K + (widu + 8 * _i) * 1024), 16, 0, 0); \
    _Pragma("unroll") for (int _i = 0; _i < 2; ++_i) __builtin_amdgcn_global_load_lds((const unsigned*)(Vh + (long)(k0) * LDV + voff[_i]), (LAS unsigned*)(ldsl + (b) * SHM_V + (widu + 8 * _i) * 1024), 16, 0, 0); } while (0)
#define RESC(a) do { if (__any((a) < 1.f)) { if (hi == 0) al_l[r32] = (a); asm volatile("s_waitcnt lgkmcnt(0)" ::: "memory"); \
    for (int d = 0; d < 4; ++d) for (int r = 0; r < 16; ++r) o[d][r] *= al_l[crow(r, hi)]; } } while (0)
  f32x16 pA0, pA1, pB0, pB1; bf16x8 pa0, pa1, pa2, pa3; const int NTL = seq / KVBLK;
  SDMA(0, 0); SDMA(1, KVBLK); asm volatile("s_waitcnt vmcnt(0)" ::: "memory"); __syncthreads();
  qkt(pA0, pA1, K_lds, qr, qrl, r32, hi);
  int bp = 0, bc = 1, bn = 2;
  for (int j = 1; j + 1 < NTL; j += 2) {
    SDMA(bn, (j + 1) * KVBLK);
    SBAR(); qkt(pB0, pB1, K_lds + bc * SHM_K, qr, qrl, r32, hi); softmaxP(pA0, pA1, l_reg, pa0, pa1, pa2, pa3); SBAR();
    pv_d0(o, vb0 + bp * (int)SHM_V, pa0, pa1, pa2, pa3);
    asm volatile("s_waitcnt vmcnt(0)" ::: "memory"); __syncthreads();
    { const int t = bp; bp = bc; bc = bn; bn = t; }
    if (j + 2 < NTL) SDMA(bn, (j + 2) * KVBLK);
    SBAR(); qkt(pA0, pA1, K_lds + bc * SHM_K, qr, qrl, r32, hi); softmaxP(pB0, pB1, l_reg, pa0, pa1, pa2, pa3); SBAR();
    pv_d0(o, vb0 + bp * (int)SHM_V, pa0, pa1, pa2, pa3);
    asm volatile("s_waitcnt vmcnt(0)" ::: "memory"); __syncthreads();
    { const int t = bp; bp = bc; bc = bn; bn = t; }
  }
  SBAR(); qkt(pB0, pB1, K_lds + bc * SHM_K, qr, qrl, r32, hi); softmaxP(pA0, pA1, l_reg, pa0, pa1, pa2, pa3); SBAR();
  pv_d0(o, vb0 + bp * (int)SHM_V, pa0, pa1, pa2, pa3);
  softmaxP(pB0, pB1, l_reg, pa0, pa1, pa2, pa3); SBAR();
  pv_d0(o, vb0 + bc * (int)SHM_V, pa0, pa1, pa2, pa3);
  if (hi == 0) li_l[r32] = l_reg; asm volatile("s_waitcnt lgkmcnt(0)" ::: "memory");
  float rli[16];
#pragma unroll
  for (int r = 0; r < 16; ++r) rli[r] = __builtin_amdgcn_rcpf(li_l[crow(r, hi)]);
  bf16_t* Ow = Ob + (long)(wid * QBLK) * LDO;
  unsigned short zv[16][4];
#pragma unroll
  for (int r = 0; r < 16; ++r) { const int orow = crow(r, hi);
#pragma unroll
    for (int d0 = 0; d0 < 4; ++d0) zv[r][d0] = Ow[(long)orow * LDO + d0 * 32 + r32]; }
#pragma unroll
  for (int r = 0; r < 16; ++r) { const int orow = crow(r, hi);
#pragma unroll
    for (int d0 = 0; d0 < 4; ++d0) Ow[(long)orow * LDO + d0 * 32 + r32] = (bf16_t)(cvt_pk_bf16(o[d0][r] * rli[r] * bf2f(zv[r][d0]), 0.f) & 0xffff); }
  __syncthreads();
#undef SDMA
#undef RESC
}
template <int SCR> __device__ void phase_attn(const Params& p, unsigned char* smem, int nrep) {
  const int G = gridDim.x;
  const bf16_t* Q = (const bf16_t*)(p.ws + WS_QA); const bf16_t* K = (const bf16_t*)(p.ws + WS_KB); const bf16_t* V = (const bf16_t*)(p.ws + WS_V2); bf16_t* O = (bf16_t*)(p.ws + (SCR ? WS_U : WS_ZA));
  for (int item = blockIdx.x; item < 1024; item += G) {
    const int b = item >> 8, c = item & 255, xcd = c & 7, jj = c >> 3, h = 2 * xcd + (jj >> 4), qb = jj & 15;
    for (int rep = 0; rep < nrep; ++rep)
    attn_body(Q + ((size_t)b * SEQ + qb * 256) * LDQ + h * DQ, K + (size_t)b * SKV * LDK + h * DQ, V + (size_t)b * SKV * LDV + h * 128, (rep + 1 == nrep ? O : (bf16_t*)(p.ws + WS_U)) + ((size_t)b * SEQ + qb * 256) * LDO + h * 128, SKV, (char*)smem);
  }
}
}
constexpr int N_PHASES = 12;
#define XB_TMO      128
#define XB_XCNT(j)  (256  + 64 * (j))
#define XB_XSUB(j)  (1280 + 64 * (j))
#define XB_XGEN(j)  (2304 + 64 * (j))
#define XB_TOP      3328
#define XB_TOPGEN   3392
#define XCD_BAR_WORDS 3456
#define XB_SPIN_CAP (1u << 22)
__device__ __forceinline__ unsigned xb_ld(unsigned* p)              { return __hip_atomic_load(p, __ATOMIC_RELAXED, __HIP_MEMORY_SCOPE_AGENT); }
__device__ __forceinline__ unsigned xb_add(unsigned* p, unsigned v) { return __hip_atomic_fetch_add(p, v, __ATOMIC_RELAXED, __HIP_MEMORY_SCOPE_AGENT); }
__device__ __forceinline__ unsigned xb_xcc_id() { return (unsigned)__builtin_amdgcn_s_getreg((3 << 11) | 20) & 0xFu; }
#define XB_SPIN(cond, bar) do { unsigned _sp = 0; while (cond) { __builtin_amdgcn_s_sleep(1); \
    if ((++_sp & 255u) == 0u) { if (xb_ld(&(bar)[XB_TMO])) break; if (_sp > XB_SPIN_CAP) { atomicAdd(&(bar)[XB_TMO], 1u); break; } } } } while (0)
struct XcdBarrier { unsigned* bar; unsigned x; volatile LAS unsigned* st; };
__device__ __forceinline__ XcdBarrier xcd_barrier_post(unsigned* bar, volatile LAS unsigned* st) {
    XcdBarrier b; b.bar = bar; b.x = xb_xcc_id(); b.st = st;
    if (threadIdx.x == 0) (void)xb_add(&bar[XB_XCNT(b.x)], 1u);
    return b;
}
__device__ __forceinline__ void xcd_barrier_complete(unsigned* bar, unsigned x, unsigned& nloc, unsigned& nx) {
    const unsigned G = gridDim.x * gridDim.y * gridDim.z;
    unsigned sum, cnt, mine, sp = 0u;
    for (;;) {
        sum = 0u; cnt = 0u; mine = 0u;
#pragma unroll
        for (unsigned j = 0; j < 16; ++j) { const unsigned c = xb_ld(&bar[XB_XCNT(j)]); sum += c; cnt += (c > 0u) ? 1u : 0u; mine = (j == x) ? c : mine; }
        if (sum == G) break;
        __builtin_amdgcn_s_sleep(1);
        if ((++sp & 255u) == 0u) { if (xb_ld(&bar[XB_TMO])) break; if (sp > XB_SPIN_CAP) { atomicAdd(&bar[XB_TMO], 1u); break; } }
    }
    nloc = mine > 0u ? mine : 1u; nx = cnt > 0u ? cnt : 1u;
}
__device__ __forceinline__ void xcd_barrier(const XcdBarrier& b) {
    asm volatile("s_waitcnt vmcnt(0)" ::: "memory");
    __syncthreads();
    if (threadIdx.x == 0) {
        unsigned* bar = b.bar;
        __builtin_amdgcn_s_waitcnt(0);
        unsigned nloc = b.st[0], nx = b.st[1];
        if (nloc == 0u) { xcd_barrier_complete(bar, b.x, nloc, nx); b.st[0] = nloc; b.st[1] = nx; }
        const unsigned old = xb_add(&bar[XB_XSUB(b.x)], 1u);
        const unsigned gen = old / nloc;
        if (old + 1u == (gen + 1u) * nloc) {
            __builtin_amdgcn_fence(__ATOMIC_RELEASE, "agent");
            asm volatile("s_waitcnt vmcnt(0)" ::: "memory");
            const unsigned og = xb_add(&bar[XB_TOP], 1u);
            const unsigned tg = og / nx;
            if (og + 1u == (tg + 1u) * nx) xb_add(&bar[XB_TOPGEN], 1u);
            else XB_SPIN(xb_ld(&bar[XB_TOPGEN]) == tg, bar);
            __builtin_amdgcn_fence(__ATOMIC_ACQUIRE, "agent");
            xb_add(&bar[XB_XGEN(b.x)], 1u);
            asm volatile("s_waitcnt vmcnt(0)" ::: "memory");
        } else {
            XB_SPIN(xb_ld(&bar[XB_XGEN(b.x)]) == gen, bar);
            __builtin_amdgcn_fence(__ATOMIC_ACQUIRE, "agent");
            asm volatile("s_waitcnt vmcnt(0)" ::: "memory");
        }
    }
    __syncthreads();
}
__global__ void __launch_bounds__(NTHR) hybrid_block_fwd(Params p) {
    extern __shared__ __attribute__((aligned(16))) unsigned char smem[];
    cg::grid_group grid = cg::this_grid();
    const int lo = p.ph_lo, hi = p.ph_hi, G = gridDim.x, bid = blockIdx.x;
    LAS unsigned char* lds = (LAS unsigned char*)smem;
    volatile LAS unsigned* xst = (volatile LAS unsigned*)(lds + LDS_BYTES - 16);
    if (threadIdx.x < 4) xst[threadIdx.x] = 0u;
    __syncthreads();
    XcdBarrier xbar = xcd_barrier_post((unsigned*)(p.ws + WS_BAR), xst);
    if (hi - lo > 1) grid.sync();
    bf16_t* GM = (bf16_t*)p.out;
#ifndef PHMASK
#define PHMASK 0xFFFF
#endif
#define IN(k) (((PHMASK >> (k)) & 1) && lo <= (k) && (k) < hi)
#define SEAM(k) do { if (IN(k) && IN((k) + 1)) xcd_barrier(xbar); } while (0)
    if (IN(0)) phase_prep(p, smem);
    SEAM(0);
    if (IN(1)) phase_hrows(p, smem);
    SEAM(1);
    if (IN(2)) { pg8::Gemm g{(const bf16_t*)(p.ws + WS_H), (const bf16_t*)(p.ws + WS_WIN), 2048, LDH}; pg8::Order S; S.init(64, 71, 4, 15, G, bid); pg8::EpiG1 E{p.ws, GM}; pg8::gemm_phase(lds, g, S, E); }
    SEAM(2);
    if (IN(3)) ml::phase_conv(p);
    SEAM(3);
    if (IN(4)) ml::phase_mlstm(p, smem);
    SEAM(4);
    if (IN(5)) phase_elem(p);
    SEAM(5);
    if (IN(6)) { pg8::Gemm g{(const bf16_t*)(p.ws + WS_CKV), (const bf16_t*)(p.ws + WS_WUKV), 512, 512}; pg8::Order S; S.init(68, 16, 0, 1, G, bid); pg8::EpiG2 E{p.ws}; pg8::gemm_phase(lds, g, S, E); }
    SEAM(6);
    if (IN(7)) phase_kfin(p);
    SEAM(7);
    if (IN(8)) att::phase_attn<0>(p, smem, 1);
    SEAM(8);
    if (IN(9)) { pg8::Gemm g{(const bf16_t*)(p.ws + WS_GMZ), (const bf16_t*)(p.ws + WS_WPM), 2048, 2048}; pg8::Order S; S.init(64, 8, 0, 1, G, bid); pg8::EpiPM<0> E{(bf16_t*)(p.ws + WS_U), GM}; pg8::gemm_phase(lds, g, S, E); }
    if (IN(10)) { pg8::Gemm g{(const bf16_t*)(p.ws + WS_ZA), (const bf16_t*)(p.ws + WS_WPA), 2048, 2048}; pg8::Order S; S.init(64, 8, 0, 1, G, bid); pg8::EpiPM<1> E{(bf16_t*)(p.ws + WS_U), GM + (size_t)NT * 2048}; pg8::gemm_phase(lds, g, S, E); }
    SEAM(10);
    if (IN(11)) { pg8::Gemm g{(const bf16_t*)(p.ws + WS_U), (const bf16_t*)(p.ws + WS_WOUT), 2048, 2048}; pg8::Order S; S.init(64, 8, 0, 1, G, bid); pg8::EpiOut E{p.x, p.out, (const float*)(p.ws + WS_MOD) + 4096}; pg8::gemm_phase(lds, g, S, E); }
#undef IN
#undef SEAM
}

extern "C" void kernel_launch(void* const* d_in, const int* in_sizes, int n_in, void* d_out, int out_size, void* d_ws, size_t ws_size, hipStream_t stream) {
    static int grid = 0;
    if (grid == 0) {
        if (n_in != 20 || out_size != NT * DM || ws_size < WS_END) { fprintf(stderr, "kernel_launch: unexpected shapes (n_in %d out %d ws %zu need %zu)\n", n_in, out_size, ws_size, (size_t)WS_END); grid = -1; return; }
        int dev = 0, cus = 0, per_cu = 0;
        hipGetDevice(&dev); hipDeviceGetAttribute(&cus, hipDeviceAttributeMultiprocessorCount, dev);
        if (hipFuncSetAttribute((const void*)hybrid_block_fwd, hipFuncAttributeMaxDynamicSharedMemorySize, LDS_BYTES) != hipSuccess) { fprintf(stderr, "kernel_launch: hipFuncSetAttribute failed\n"); grid = -1; return; }
        if (hipOccupancyMaxActiveBlocksPerMultiprocessor(&per_cu, (const void*)hybrid_block_fwd, NTHR, LDS_BYTES) != hipSuccess || per_cu < 1) { fprintf(stderr, "kernel_launch: occupancy query gave %d\n", per_cu); per_cu = 1; }
        (void)hipGetLastError();
        grid = cus * per_cu;
    }
    if (grid < 0) return;
    Params p{};
    const float** f = (const float**)&p;
    for (int i = 0; i < 20; ++i) f[i] = (const float*)d_in[i];
    p.out = (float*)d_out; p.ws = (unsigned char*)d_ws;
    if (hipMemsetAsync((unsigned char*)d_ws + WS_BAR, 0, XCD_BAR_WORDS * 4, stream) != hipSuccess) { fprintf(stderr, "kernel_launch: memset failed\n"); return; }
    p.ph_lo = 0; p.ph_hi = N_PHASES;
    void* args[] = {&p};
    hipError_t e = hipLaunchCooperativeKernel((const void*)hybrid_block_fwd, dim3(grid), dim3(NTHR), args, LDS_BYTES, stream);
    if (e != hipSuccess) fprintf(stderr, "kernel_launch: cooperative launch failed: %s (grid %d)\n", hipGetErrorString(e), grid);
}
```

```cpp
#include <hip/hip_runtime.h>
#include <hip/hip_cooperative_groups.h>
#include <cstdio>
namespace cg = cooperative_groups;

#define LAS __attribute__((address_space(3)))
typedef unsigned short bf16_t;
typedef short bf16x8 __attribute__((ext_vector_type(8)));
typedef short s16x4 __attribute__((ext_vector_type(4)));
typedef float f32x4 __attribute__((ext_vector_type(4)));
typedef float f32x2 __attribute__((ext_vector_type(2)));
typedef float f32x16 __attribute__((ext_vector_type(16)));
typedef unsigned u32x4 __attribute__((ext_vector_type(4)));
typedef unsigned u32x2 __attribute__((ext_vector_type(2)));

constexpr int DM = 2048, NB = 4, SEQ = 4096, NT = NB * SEQ  , CL = 256, NC = NB * CL  , NR = NT + NC  , SKV = SEQ + CL  ;
constexpr int IN_COLS = 18016;
constexpr float EPS = 1e-6f;
constexpr int NTHR = 512;
constexpr int LDS_BYTES = 141312 + 16;

constexpr size_t al256(size_t x) { return (x + 255) / 256 * 256; }
constexpr size_t WS_MOD   = 0;
constexpr size_t WS_WUKV  = al256(WS_MOD + 5 * 6144 * 4);
constexpr size_t WS_WPM   = WS_WUKV + (size_t)4096 * 512 * 2;
constexpr size_t WS_WPA   = WS_WPM + (size_t)2048 * 2048 * 2;
constexpr size_t WS_WOUT  = WS_WPA + (size_t)2048 * 2048 * 2;
constexpr size_t WS_KM    = WS_WOUT + (size_t)2048 * 2048 * 2;
constexpr size_t WS_QM    = WS_KM + (size_t)NR * 1024 * 2;
constexpr size_t WS_VM    = WS_QM + (size_t)NT * 1024 * 2;
constexpr size_t WS_KRGT  = WS_VM + (size_t)NR * 2048 * 2;
constexpr size_t WS_CKV   = WS_KRGT + (size_t)NR * 96 * 4;
constexpr size_t WS_GMZ   = WS_CKV + (size_t)NR * 512 * 2;
constexpr size_t WS_QA    = WS_GMZ + (size_t)NT * 2048 * 2;
constexpr size_t WS_ZA    = WS_QA + (size_t)NT * 3072 * 2;
constexpr size_t WS_H     = WS_ZA + (size_t)NT * 2048 * 2;
constexpr int LDH = 2048 + 64;
constexpr size_t WS_WIN   = WS_H + (size_t)NR * LDH * 2;
constexpr size_t WS_END   = WS_WIN + (size_t)71 * 256 * LDH * 2;
constexpr size_t WS_KC    = WS_H;
constexpr size_t WS_QC    = WS_KC + (size_t)NR * 1024 * 2;
constexpr size_t WS_HF    = WS_KM;
constexpr size_t WS_HB    = WS_QC + (size_t)NT * 1024 * 2;
static_assert(WS_HF + (size_t)NT * 2048 * 2 <= WS_VM, "HF alias");
constexpr size_t WS_KB    = WS_H;
constexpr size_t WS_V2    = WS_KM;
constexpr size_t WS_U     = WS_KM + (size_t)NR * 2048 * 2;
static_assert(WS_HB + (size_t)NT * 2048 * 2 <= WS_END, "HF/HB alias");
static_assert(WS_KB + (size_t)NR * 3072 * 2 <= WS_END, "KB alias");
static_assert(WS_U + (size_t)NT * 2048 * 2 <= WS_KRGT, "U alias");
constexpr size_t WS_BAR   = WS_END;
static_assert(WS_BAR + 16384 <= 590348288ull, "workspace");

struct Params {
    const float *x, *c, *ctx, *c_ctx, *ada_w, *ada_b, *norm_g, *w_in, *conv_w, *conv_b, *gate_b, *mh_norm_g, *q_norm_g, *k_norm_g, *kv_norm_g,
                *w_uk, *w_uv, *w_proj_m, *w_proj_a, *w_out;
    float* out; unsigned char* ws; int ph_lo, ph_hi;
};

typedef __bf16 bf16x2_t __attribute__((ext_vector_type(2)));
__device__ __forceinline__ unsigned cvt_pk_bf16(float lo, float hi) { const f32x2 v = {lo, hi}; const bf16x2_t b = __builtin_convertvector(v, bf16x2_t); return __builtin_bit_cast(unsigned, b); }
__device__ __forceinline__ float bf2f(unsigned short b) { return __uint_as_float(((unsigned)b) << 16); }
__device__ __forceinline__ float bflo(unsigned w) { return __uint_as_float(w << 16); }
__device__ __forceinline__ float bfhi(unsigned w) { return __uint_as_float(w & 0xffff0000u); }
__device__ __forceinline__ float sigmoidf_(float x) { return __builtin_amdgcn_rcpf(1.0f + __expf(-x)); }
__device__ __forceinline__ float siluf_(float x) { return x * __builtin_amdgcn_rcpf(1.0f + __expf(-x)); }
__device__ __forceinline__ float wave_sum(float v) { for (int o = 32; o >= 1; o >>= 1) v += __shfl_xor(v, o); return v; }
__device__ __forceinline__ float wave_max(float v) { for (int o = 32; o >= 1; o >>= 1) v = fmaxf(v, __shfl_xor(v, o)); return v; }
namespace pg8 {
constexpr int BM = 256, BK = 64, HALF = 128, HTB = HALF * BK * 2, STAGE_BYTES = 8 * HTB, NXCD = 8, WGM = 8;
__host__ __device__ __forceinline__ int lds_byte(int r, int c) { const int st = (r >> 4) * 2 + (c >> 5), rr = r & 15, cc = c & 31, ob = rr * 64 + cc * 2; return st * 1024 + (ob ^ (((ob >> 9) & 1) << 5)); }
__host__ __device__ __forceinline__ void stage_rc(int b, int& R, int& C) { const int st = b / 1024, sb = b % 1024, swz = sb ^ (((sb >> 9) & 1) << 5); R = (st >> 1) * 16 + swz / 64; C = (st & 1) * 32 + (swz % 64) / 2; }
__host__ __device__ __forceinline__ int perm32(int rho) { const int n = rho >> 4, i = rho & 15; return 8 * (i >> 2) + 4 * n + (i & 3); }
struct Unit { int pm, pn; };
struct Gemm { const bf16_t* A; const bf16_t* Bt; int K; int ld; };
struct Order {
    int nM, nN, nwg, exN, total, G, c, wgm;
    __device__ void init(int nM_, int nN_, int exM, int exN_, int G_, int c_, int wgm_ = WGM) { nM = nM_; nN = nN_; nwg = nM * nN; exN = exN_; total = nwg + exM * exN_; G = G_; c = c_; wgm = wgm_; }
    __device__ bool next(int i, Unit& u) const {
        const long L = (long)i * G + c; if (L >= total) return false;
        if (L >= nwg) { const int idx = (int)L - nwg; u.pm = nM + idx / exN; u.pn = idx % exN; return true; }
        int wgid = (int)L; { const int q = nwg / NXCD, r = nwg % NXCD, xcd = wgid % NXCD, off = wgid / NXCD; wgid = (xcd < r ? xcd * (q + 1) : r * (q + 1) + (xcd - r) * q) + off; }
        const int nig = wgm * nN, gid = wgid / nig, fm = gid * wgm, gsz = (nM - fm) < wgm ? (nM - fm) : wgm;
        u.pm = fm + ((wgid % nig) % gsz); u.pn = (wgid % nig) / gsz; return true;
    }
};
template <class Epi>
__device__ __forceinline__ void gemm_phase(LAS unsigned char* lds, const Gemm g, const Order& S, const Epi& E) {
    const int tid = threadIdx.x, wid = __builtin_amdgcn_readfirstlane(tid >> 6), lane = tid & 63, wr = wid >> 2, wc = wid & 3, fr = lane & 15, fq = lane >> 4;
    const int K = g.K, nt = K / BK, LD = g.ld;
    unsigned voffA[2], voffB[2];
#pragma unroll
    for (int i = 0; i < 2; ++i) { int R, C; stage_rc(tid * 16 + i * 8192, R, C); const int Rb = (R & ~31) + perm32(R & 31);
        voffA[i] = (unsigned)(R * LD + C) * 2u; voffB[i] = (unsigned)(Rb * LD + C) * 2u; }
    const size_t kstep = (size_t)(BK * 2);
    const size_t hstep = (size_t)HALF * LD * 2;
    const size_t tstep = 2 * hstep;
    const unsigned ldsw = (unsigned)wid * 1024u;
    const int aoff = lds_byte(wr * 64 + fr, fq * 8), boff = lds_byte(wc * 32 + fr, fq * 8);
#define PG8_SA(b, h) (((b) * 2 + (h)) * HTB)
#define PG8_SB(b, h) ((4 + (b) * 2 + (h)) * HTB)
#define PG8_STAGE(bufoff, gbase, voff) do { _Pragma("unroll") for (int _i = 0; _i < 2; ++_i) \
        __builtin_amdgcn_global_load_lds((const unsigned*)((const char*)(gbase) + (voff)[_i]), (LAS unsigned*)(lds + (bufoff) + ldsw + _i * 8192), 16, 0, 0); } while (0)
#define PG8_LDA(dst, b, h) do { _Pragma("unroll") for (int m = 0; m < 4; ++m) _Pragma("unroll") for (int k = 0; k < 2; ++k) dst[m][k] = *(const LAS bf16x8*)(lds + PG8_SA(b, h) + aoff + m * 2048 + k * 1024); } while (0)
#define PG8_LDB(dst, b, h) do { _Pragma("unroll") for (int n = 0; n < 2; ++n) _Pragma("unroll") for (int k = 0; k < 2; ++k) dst[n][k] = *(const LAS bf16x8*)(lds + PG8_SB(b, h) + boff + n * 2048 + k * 1024); } while (0)
#define PG8_MMA(ai, bj, At, Bt) do { __builtin_amdgcn_s_setprio(1); _Pragma("unroll") for (int m = 0; m < 4; ++m) _Pragma("unroll") for (int n = 0; n < 2; ++n) _Pragma("unroll") for (int k = 0; k < 2; ++k) \
        acc[ai][bj][m][n] = __builtin_amdgcn_mfma_f32_16x16x32_bf16(Bt[n][k], At[m][k], acc[ai][bj][m][n], 0, 0, 0); __builtin_amdgcn_s_setprio(0); } while (0)
#define PG8_WAIT_V(n) asm volatile("s_waitcnt vmcnt(" #n ")" ::: "memory")
#define PG8_WAIT_L(n) asm volatile("s_waitcnt lgkmcnt(" #n ")" ::: "memory")
#define PG8_BAR __builtin_amdgcn_s_barrier()
#define PG8_SCHED __builtin_amdgcn_sched_barrier(0)
    Unit cur, nxt; int ui = 0;
    if (!S.next(0, cur)) return;
    f32x4 acc[2][2][4][2];
#pragma unroll
    for (int a = 0; a < 2; ++a)
#pragma unroll
        for (int b = 0; b < 2; ++b)
#pragma unroll
            for (int m = 0; m < 4; ++m)
#pragma unroll
                for (int n = 0; n < 2; ++n) acc[a][b][m][n] = (f32x4){0.f, 0.f, 0.f, 0.f};
    bf16x8 At[4][2], B0[2][2], B1[2][2];
    const char* cA = (const char*)g.A + (size_t)cur.pm * tstep; const char* cB = (const char*)g.Bt + (size_t)cur.pn * tstep;
    PG8_STAGE(PG8_SB(0, 0), cB, voffB); PG8_STAGE(PG8_SA(0, 0), cA, voffA); PG8_STAGE(PG8_SB(0, 1), cB + hstep, voffB); PG8_STAGE(PG8_SA(0, 1), cA + hstep, voffA);
    if (wr == 1) PG8_BAR;
    PG8_WAIT_V(4); PG8_BAR;
    PG8_STAGE(PG8_SB(1, 0), cB + kstep, voffB); PG8_STAGE(PG8_SA(1, 0), cA + kstep, voffA); PG8_STAGE(PG8_SB(1, 1), cB + hstep + kstep, voffB);
    PG8_WAIT_V(6); PG8_BAR;
    for (;;) {
        const bool has_next = S.next(ui + 1, nxt);
        const char* nA = has_next ? (const char*)g.A + (size_t)nxt.pm * tstep : cA; const char* nB = has_next ? (const char*)g.Bt + (size_t)nxt.pn * tstep : cB;
        for (int t = 0; t < nt; t += 2) {
            const bool last = (t == nt - 2);
            const char* a1 = cA + (size_t)(t + 1) * kstep;
            const char* a2 = last ? nA : cA + (size_t)(t + 2) * kstep; const char* b2 = last ? nB : cB + (size_t)(t + 2) * kstep;
            const char* a3 = a2 + kstep; const char* b3 = b2 + kstep;
            PG8_LDB(B0, 0, 0); PG8_SCHED; PG8_LDA(At, 0, 0); PG8_STAGE(PG8_SA(1, 1), a1 + hstep, voffA);
            PG8_WAIT_L(8); PG8_BAR; PG8_WAIT_L(0); PG8_MMA(0, 0, At, B0); PG8_BAR; PG8_SCHED;
            PG8_LDB(B1, 0, 1); PG8_STAGE(PG8_SB(0, 0), b2, voffB);
            PG8_BAR; PG8_WAIT_L(0); PG8_MMA(0, 1, At, B1); PG8_BAR;
            PG8_LDA(At, 0, 1); PG8_STAGE(PG8_SA(0, 0), a2, voffA);
            PG8_BAR; PG8_WAIT_L(0); PG8_MMA(1, 0, At, B0); PG8_BAR; PG8_SCHED;
            PG8_STAGE(PG8_SB(0, 1), b2 + hstep, voffB);
            PG8_WAIT_V(6); PG8_BAR; PG8_MMA(1, 1, At, B1); PG8_BAR;
            PG8_LDB(B0, 1, 0); PG8_SCHED; PG8_LDA(At, 1, 0); PG8_STAGE(PG8_SA(0, 1), a2 + hstep, voffA);
            PG8_WAIT_L(8); PG8_BAR; PG8_WAIT_L(0); PG8_MMA(0, 0, At, B0); PG8_BAR; PG8_SCHED;
            PG8_LDB(B1, 1, 1); PG8_STAGE(PG8_SB(1, 0), b3, voffB);
            PG8_BAR; PG8_WAIT_L(0); PG8_MMA(0, 1, At, B1); PG8_BAR;
            PG8_LDA(At, 1, 1); PG8_STAGE(PG8_SA(1, 0), a3, voffA);
            PG8_BAR; PG8_WAIT_L(0); PG8_MMA(1, 0, At, B0); PG8_BAR; PG8_SCHED;
            PG8_STAGE(PG8_SB(1, 1), b3 + hstep, voffB);
            PG8_WAIT_V(6); PG8_BAR; PG8_MMA(1, 1, At, B1); PG8_BAR;
        }
        E(acc, cur, wr, wc, fr, fq);
        if (!has_next) break;
#pragma unroll
        for (int a = 0; a < 2; ++a)
#pragma unroll
            for (int b = 0; b < 2; ++b)
#pragma unroll
                for (int m = 0; m < 4; ++m)
#pragma unroll
                    for (int n = 0; n < 2; ++n) acc[a][b][m][n] = (f32x4){0.f, 0.f, 0.f, 0.f};
        cur = nxt; cA = nA; cB = nB; ++ui;
    }
    PG8_WAIT_V(0);
    if (wr == 0) PG8_BAR;
    PG8_BAR;
#undef PG8_SA
#undef PG8_SB
#undef PG8_STAGE
#undef PG8_LDA
#undef PG8_LDB
#undef PG8_MMA
#undef PG8_WAIT_V
#undef PG8_WAIT_L
#undef PG8_BAR
#undef PG8_SCHED
}

__device__ __forceinline__ u32x4 pack8(f32x4 v0, f32x4 v1) { u32x4 w; w.x = cvt_pk_bf16(v0[0], v0[1]); w.y = cvt_pk_bf16(v0[2], v0[3]); w.z = cvt_pk_bf16(v1[0], v1[1]); w.w = cvt_pk_bf16(v1[2], v1[3]); return w; }
__device__ __forceinline__ f32x4 sig4(f32x4 v) { return (f32x4){sigmoidf_(v[0]), sigmoidf_(v[1]), sigmoidf_(v[2]), sigmoidf_(v[3])}; }
__device__ __forceinline__ f32x4 silu4(f32x4 v) { return (f32x4){siluf_(v[0]), siluf_(v[1]), siluf_(v[2]), siluf_(v[3])}; }

struct EpiG1 {
    unsigned char* ws; bf16_t* gm;
    __device__ __forceinline__ void operator()(const f32x4 (&acc)[2][2][4][2], const Unit& u, int wr, int wc, int fr, int fq) const {
        const int pn = u.pn; const size_t row0 = (size_t)u.pm * BM + wr * 64 + fr; const int lc = wc * 32 + 8 * fq;
        if (pn == 14) {
            float* O = (float*)(ws + WS_KRGT);
            if (lc < 96) {
#pragma unroll
                for (int ai = 0; ai < 2; ++ai)
#pragma unroll
                    for (int m = 0; m < 4; ++m) { float* rp = O + (row0 + ai * HALF + m * 16) * 96 + lc; *(f32x4*)rp = acc[ai][0][m][0]; *(f32x4*)(rp + 4) = acc[ai][0][m][1]; }
            }
            return;
        }
        if (pn >= 19 && pn < 35) {
            bf16_t* O = (bf16_t*)(ws + WS_GMZ) + (pn - 19) * 128 + lc;
#pragma unroll
            for (int ai = 0; ai < 2; ++ai)
#pragma unroll
                for (int m = 0; m < 4; ++m) { const f32x4 a0 = sig4(acc[ai][0][m][0]) * silu4(acc[ai][1][m][0]), a1 = sig4(acc[ai][0][m][1]) * silu4(acc[ai][1][m][1]);
                    __builtin_nontemporal_store(pack8(a0, a1), (u32x4*)(O + (row0 + ai * HALF + m * 16) * 2048)); }
            return;
        }
        bf16_t* O; int ld, act = 0;
        if (pn < 4) { O = (bf16_t*)(ws + WS_KM) + pn * 256; ld = 1024; }
        else if (pn < 12) { O = (bf16_t*)(ws + WS_VM) + (pn - 4) * 256; ld = 2048; }
        else if (pn < 14) { O = (bf16_t*)(ws + WS_CKV) + (pn - 12) * 256; ld = 512; }
        else if (pn < 19) { O = (bf16_t*)(ws + WS_QM) + (pn - 15) * 256; ld = 1024; }
        else if (pn < 47) { O = (bf16_t*)(ws + WS_QA) + (pn - 35) * 256; ld = 3072; }
        else if (pn < 55) { O = (bf16_t*)(ws + WS_ZA) + (pn - 47) * 256; ld = 2048; act = 1; }
        else if (pn < 63) { O = gm + (pn - 55) * 256; ld = 2048; act = 2; }
        else { O = gm + (size_t)NT * 2048 + (pn - 63) * 256; ld = 2048; act = 2; }
        O += lc;
#pragma unroll
        for (int ai = 0; ai < 2; ++ai)
#pragma unroll
            for (int m = 0; m < 4; ++m) { bf16_t* rp = O + (row0 + ai * HALF + m * 16) * ld;
#pragma unroll
                for (int bj = 0; bj < 2; ++bj) { f32x4 v0 = acc[ai][bj][m][0], v1 = acc[ai][bj][m][1];
                    if (act == 1) { v0 = silu4(v0); v1 = silu4(v1); } else if (act == 2) { v0 = sig4(v0); v1 = sig4(v1); }
                    __builtin_nontemporal_store(pack8(v0, v1), (u32x4*)(rp + bj * HALF)); } }
    }
};
struct EpiG2 {
    unsigned char* ws;
    __device__ __forceinline__ void operator()(const f32x4 (&acc)[2][2][4][2], const Unit& u, int wr, int wc, int fr, int fq) const {
        const int pn = u.pn, pm = u.pm; const int lc = wc * 32 + 8 * fq;
        const size_t obase = pm < 64 ? (size_t)(pm >> 4) * SKV + CL + (size_t)(pm & 15) * 256 : (size_t)(pm - 64) * SKV;
        const size_t row0 = obase + wr * 64 + fr;
#pragma unroll
        for (int ai = 0; ai < 2; ++ai)
#pragma unroll
            for (int m = 0; m < 4; ++m) { const size_t r = row0 + ai * HALF + m * 16;
#pragma unroll
                for (int bj = 0; bj < 2; ++bj) {
                    bf16_t* p = pn < 8 ? (bf16_t*)(ws + WS_KB) + r * 3072 + (2 * pn + bj) * 192 + lc : (bf16_t*)(ws + WS_V2) + r * 2048 + (pn - 8) * 256 + bj * HALF + lc;
                    *(u32x4*)p = pack8(acc[ai][bj][m][0], acc[ai][bj][m][1]); } }
    }
};
__device__ __forceinline__ void unpack8(u32x4 w, f32x4& a, f32x4& b) { a = (f32x4){bflo(w.x), bfhi(w.x), bflo(w.y), bfhi(w.y)}; b = (f32x4){bflo(w.z), bfhi(w.z), bflo(w.w), bfhi(w.w)}; }
template <int ADD> struct EpiPM {
    bf16_t* U; const bf16_t* gate;
    __device__ __forceinline__ void operator()(const f32x4 (&acc)[2][2][4][2], const Unit& u, int wr, int wc, int fr, int fq) const {
        const size_t row0 = (size_t)u.pm * BM + wr * 64 + fr; const int col0 = u.pn * BM + wc * 32 + 8 * fq;
#pragma unroll
        for (int ai = 0; ai < 2; ++ai) {
            u32x4 gw[4][2], uw[4][2];
#pragma unroll
            for (int m = 0; m < 4; ++m)
#pragma unroll
                for (int bj = 0; bj < 2; ++bj) { const size_t off = (row0 + ai * HALF + m * 16) * 2048 + col0 + bj * HALF;
                    gw[m][bj] = *(const u32x4*)(gate + off); if (ADD) uw[m][bj] = *(const u32x4*)(U + off); }
#pragma unroll
            for (int m = 0; m < 4; ++m)
#pragma unroll
                for (int bj = 0; bj < 2; ++bj) { const size_t off = (row0 + ai * HALF + m * 16) * 2048 + col0 + bj * HALF;
                    f32x4 g0, g1; unpack8(gw[m][bj], g0, g1);
                    f32x4 v0 = g0 * acc[ai][bj][m][0], v1 = g1 * acc[ai][bj][m][1];
                    if (ADD) { f32x4 p0, p1; unpack8(uw[m][bj], p0, p1); v0 += p0; v1 += p1; }
                    *(u32x4*)(U + off) = pack8(v0, v1); }
        }
    }
};
struct EpiOut {
    const float* x; float* out; const float* gate;
    __device__ __forceinline__ void operator()(const f32x4 (&acc)[2][2][4][2], const Unit& u, int wr, int wc, int fr, int fq) const {
        const size_t row0 = (size_t)u.pm * BM + wr * 64 + fr; const int col0 = u.pn * BM + wc * 32 + 8 * fq; const float* gp = gate + (size_t)(u.pm >> 4) * 6144 + col0;
        f32x4 gv[2][2];
#pragma unroll
        for (int bj = 0; bj < 2; ++bj) { gv[bj][0] = *(const f32x4*)(gp + bj * HALF); gv[bj][1] = *(const f32x4*)(gp + bj * HALF + 4); }
#pragma unroll
        for (int ai = 0; ai < 2; ++ai) {
            f32x4 xv[4][2][2];
#pragma unroll
            for (int m = 0; m < 4; ++m)
#pragma unroll
                for (int bj = 0; bj < 2; ++bj) { const size_t off = (row0 + ai * HALF + m * 16) * 2048 + col0 + bj * HALF; xv[m][bj][0] = *(const f32x4*)(x + off); xv[m][bj][1] = *(const f32x4*)(x + off + 4); }
#pragma unroll
            for (int m = 0; m < 4; ++m)
#pragma unroll
                for (int bj = 0; bj < 2; ++bj) { const size_t off = (row0 + ai * HALF + m * 16) * 2048 + col0 + bj * HALF;
                    *(f32x4*)(out + off) = xv[m][bj][0] + gv[bj][0] * acc[ai][bj][m][0]; *(f32x4*)(out + off + 4) = xv[m][bj][1] + gv[bj][1] * acc[ai][bj][m][1]; }
        }
    }
};
}
__device__ __forceinline__ int win_src(int nq) {
    const int pn = nq >> 3, r = (nq & 7) * 32;
    if (pn < 4) return pn * 256 + r;
    if (pn < 12) return 1024 + (pn - 4) * 256 + r;
    if (pn < 14) return 3104 + (pn - 12) * 256 + r;
    if (pn == 14) return r < 64 ? 3616 + r : (r == 64 ? 3072 : -1);
    if (pn < 19) return 3680 + (pn - 15) * 256 + r;
    if (pn < 35) { const int j0 = (pn - 19) * 128; return r < 128 ? 4704 + j0 + r : 6752 + j0 + (r - 128); }
    if (pn < 47) return 8800 + (pn - 35) * 256 + r;
    if (pn < 55) return 11872 + (pn - 47) * 256 + r;
    return 13920 + (pn - 55) * 256 + r;
}
__device__ __forceinline__ void tr_addr(const Params& p, int t, const float*& q  , bf16_t*& dstp  ) {
    constexpr int T_WIN = 284 * 32, T_UKV = 64 * 8;
    const int tid = threadIdx.x, kk = tid >> 3, jg = (tid & 7) * 8, hi32 = jg >> 5, n = tid >> 3, kg = (tid & 7) * 8;
    if (t < T_WIN) { const int nt = t % 284, kt = t / 284; const int c = win_src(nt * 2 + hi32);
        q = c >= 0 ? p.w_in + (size_t)(kt * 64 + kk) * IN_COLS + c + (jg & 31) : nullptr;
        dstp = (bf16_t*)(p.ws + WS_WIN) + (size_t)(nt * 64 + n) * LDH + kt * 64 + kg; }
    else if (t < T_WIN + T_UKV) { const int u = t - T_WIN, nt = u >> 3, kt = u & 7;
        q = (nt < 32 ? p.w_uk + nt * 64 : p.w_uv + (nt - 32) * 64) + (size_t)(kt * 64 + kk) * 2048 + jg;
        dstp = (bf16_t*)(p.ws + WS_WUKV) + (size_t)(nt * 64 + n) * 512 + kt * 64 + kg; }
    else { const int u = t - T_WIN - T_UKV, which = u >> 10, nt = (u >> 5) & 31, kt = u & 31;
        q = (which == 0 ? p.w_proj_m : which == 1 ? p.w_proj_a : p.w_out) + (size_t)(kt * 64 + kk) * 2048 + nt * 64 + jg;
        dstp = (bf16_t*)(p.ws + (which == 0 ? WS_WPM : which == 1 ? WS_WPA : WS_WOUT)) + (size_t)(nt * 64 + n) * 2048 + kt * 64 + kg; }
}
__device__ __forceinline__ void tr_load(const float* q, f32x4& a, f32x4& b) {
    a = (f32x4){0.f, 0.f, 0.f, 0.f}; b = a;
    if (q) { a = *(const f32x4*)q; b = *(const f32x4*)(q + 4); }
}
__device__ __forceinline__ void tr_store(float* tile  , bf16_t* dstp, const f32x4 a, const f32x4 b) {
    const int tid = threadIdx.x;
    { const int kk = tid >> 3, jg = (tid & 7) * 8; float* t = tile + kk * 65 + jg; t[0] = a[0]; t[1] = a[1]; t[2] = a[2]; t[3] = a[3]; t[4] = b[0]; t[5] = b[1]; t[6] = b[2]; t[7] = b[3]; }
    __syncthreads();
    { const int n = tid >> 3, kg = (tid & 7) * 8; const float* t = tile + kg * 65 + n;
      u32x4 w; w.x = cvt_pk_bf16(t[0], t[65]); w.y = cvt_pk_bf16(t[130], t[195]); w.z = cvt_pk_bf16(t[260], t[325]); w.w = cvt_pk_bf16(t[390], t[455]);
      *(u32x4*)dstp = w; }
}
__device__ void phase_prep(const Params& p, unsigned char* smem) {
    const int tid = threadIdx.x, G = gridDim.x, bid = blockIdx.x;
    float* sm = (float*)smem;
    if (bid < 256) {
        float* sv = sm;
        float* red = sm + 5 * 2048;
        for (int i = tid; i < 5 * 2048; i += NTHR) { const int v = i >> 11, k = i & 2047; const float cv = v < 4 ? p.c[v * 2048 + k] : p.c_ctx[k]; sv[i] = siluf_(cv); }
        __syncthreads();
        for (int cgp = bid; cgp < 256; cgp += G) {
            const int col = tid % 24, kg = tid / 24;
            if (kg < 21) { float a0 = 0, a1 = 0, a2 = 0, a3 = 0, a4 = 0; const float* w = p.ada_w + cgp * 24 + col;
                for (int k0 = kg; k0 < 2048; k0 += 21 * 14) {
                    float wv[14];
#pragma unroll
                    for (int u = 0; u < 14; ++u) { const int k = k0 + 21 * u; wv[u] = k < 2048 ? w[(size_t)k * 6144] : 0.f; }
#pragma unroll
                    for (int u = 0; u < 14; ++u) { const int k = k0 + 21 * u; if (k < 2048) { a0 += sv[k] * wv[u]; a1 += sv[2048 + k] * wv[u]; a2 += sv[4096 + k] * wv[u]; a3 += sv[6144 + k] * wv[u]; a4 += sv[8192 + k] * wv[u]; } }
                }
                float* r = red + (kg * 24 + col) * 5; r[0] = a0; r[1] = a1; r[2] = a2; r[3] = a3; r[4] = a4; }
            __syncthreads();
            if (tid < 120) { const int c2 = tid / 5, v = tid % 5; float s = 0; for (int g = 0; g < 21; ++g) s += red[(g * 24 + c2) * 5 + v];
                ((float*)(p.ws + WS_MOD))[v * 6144 + cgp * 24 + c2] = s + p.ada_b[cgp * 24 + c2]; }
            __syncthreads();
        }
    }
    float* tile = sm;
    constexpr int T_ALL = 284 * 32 + 64 * 8 + 3 * 32 * 32;
    const int n = bid < T_ALL ? (T_ALL - bid + G - 1) / G : 0;
    f32x4 A4[4], B4[4]; bf16_t* D4[4];
#pragma unroll
    for (int u = 0; u < 4; ++u) { A4[u] = (f32x4){0.f, 0.f, 0.f, 0.f}; B4[u] = A4[u]; D4[u] = nullptr; if (u < n) { const float* q; tr_addr(p, bid + u * G, q, D4[u]); tr_load(q, A4[u], B4[u]); } }
    for (int k0 = 0; k0 < n; k0 += 4) {
#pragma unroll
        for (int u = 0; u < 4; ++u) { const int k = k0 + u;
            if (k < n) { tr_store(tile + (u & 1) * (64 * 65), D4[u], A4[u], B4[u]);
                if (k + 4 < n) { const float* q; tr_addr(p, bid + (k + 4) * G, q, D4[u]); tr_load(q, A4[u], B4[u]); } } }
    }
}
__device__ void phase_hrows(const Params& p, unsigned char* smem) {
    const int tid = threadIdx.x, G = gridDim.x, lane = tid & 63, wid = tid >> 6;
    float* red = (float*)smem;
    const float* MOD = (const float*)(p.ws + WS_MOD);
    const f32x4 g = *(const f32x4*)(p.norm_g + tid * 4);
    int it = 0, vcur = -1; f32x4 sh = (f32x4){0.f, 0.f, 0.f, 0.f}, sc = sh;
    auto rowptr = [&](int r) { return (r < NT ? p.x + (size_t)r * 2048 : p.ctx + (size_t)(r - NT) * 2048) + tid * 4; };
    f32x4 xq[4];
#pragma unroll
    for (int u = 0; u < 4; ++u) { const int r = blockIdx.x + u * G; xq[u] = (f32x4){0.f, 0.f, 0.f, 0.f}; if (r < NR) xq[u] = *(const f32x4*)rowptr(r); }
    for (int row0 = blockIdx.x; row0 < NR; row0 += 4 * G)
#pragma unroll
    for (int u = 0; u < 4; ++u) { const int row = row0 + u * G; if (row < NR) { ++it;
        const int v = row < NT ? row >> 12 : 4;
        const f32x4 xv = xq[u];
        { const int rn = row + 4 * G; if (rn < NR) xq[u] = *(const f32x4*)rowptr(rn); }
        float ss = xv[0] * xv[0] + xv[1] * xv[1] + xv[2] * xv[2] + xv[3] * xv[3];
        ss = wave_sum(ss);
        float* r = red + (it & 1) * 8;
        if (lane == 0) r[wid] = ss;
        __syncthreads();
        float tot = 0;
#pragma unroll
        for (int i = 0; i < 8; ++i) tot += r[i];
        const float rstd = rsqrtf(tot * (1.0f / 2048.0f) + EPS);
        if (v != vcur) { sh = *(const f32x4*)(MOD + v * 6144 + tid * 4); sc = *(const f32x4*)(MOD + v * 6144 + 2048 + tid * 4); vcur = v; }
        const f32x4 y = xv * rstd * g * (sc + 1.0f) + sh;
        u32x2 w; w.x = cvt_pk_bf16(y[0], y[1]); w.y = cvt_pk_bf16(y[2], y[3]);
        *(u32x2*)((bf16_t*)(p.ws + WS_H) + (size_t)row * LDH + tid * 4) = w;
    } }
    __syncthreads();
}
namespace ml {
constexpr int QS = 136, KTS = 72, CTS = 136;
constexpr int OFF_Q = 0, OFF_K = 17408, OFF_KT = 34816, OFF_VT = 53248, OFF_VWT = 62464, OFF_P = 71680, OFF_CT = 80896, OFF_F = 98304;
constexpr int F_N = 0, F_ROWC = 128, F_AV = 192, F_SINT = 256, F_EINV = 320, F_WS = 384, F_PSUM = 448, F_QN = 576, F_CWQ = 640, F_CWK = 1280, F_CBQ = 1920, F_CBK = 2048;
__device__ __forceinline__ int crow(int r, int hi) { return (r & 3) + 8 * (r >> 2) + 4 * hi; }
__device__ __forceinline__ bf16x8 ldfrag(const unsigned char* base, int row, int stride, int k) { return *(const bf16x8*)(base + ((size_t)row * stride + k) * 2); }


template <int CTRL, int ROWMASK> __device__ __forceinline__ float dpp_f(float oldv, float src) {
    return __int_as_float(__builtin_amdgcn_update_dpp(__float_as_int(oldv), __float_as_int(src), CTRL, ROWMASK, 0xf, false)); }
__device__ __forceinline__ float scan_add64(float x) {
    x += dpp_f<0x111, 0xf>(0.f, x); x += dpp_f<0x112, 0xf>(0.f, x); x += dpp_f<0x114, 0xf>(0.f, x); x += dpp_f<0x118, 0xf>(0.f, x);
    x += dpp_f<0x142, 0xa>(0.f, x); x += dpp_f<0x143, 0xc>(0.f, x); return x; }
__device__ __forceinline__ float scan_max64(float x) {
    constexpr float NEG = -3.0e38f;
    x = fmaxf(x, dpp_f<0x111, 0xf>(NEG, x)); x = fmaxf(x, dpp_f<0x112, 0xf>(NEG, x)); x = fmaxf(x, dpp_f<0x114, 0xf>(NEG, x)); x = fmaxf(x, dpp_f<0x118, 0xf>(NEG, x));
    x = fmaxf(x, dpp_f<0x142, 0xa>(NEG, x)); x = fmaxf(x, dpp_f<0x143, 0xc>(NEG, x)); return x; }

__device__ void phase_conv(const Params& p) {
    const int tid = threadIdx.x, G = gridDim.x;
    constexpr int NKI = (NR / 64) * 8, NQI = (NT / 64) * 8, NI = NKI + NQI;
    const int i = tid >> 3;
    auto load_item = [&](int item, u32x4 (&W)[10]) {
        const bool isq = item >= NKI; const int it = isq ? item - NKI : item; const int h = it & 7, row0 = (it >> 3) * 64;
        const int seq0 = row0 < NT ? (row0 & ~(SEQ - 1)) : NT + ((row0 - NT) & ~(CL - 1)), seqlen = row0 < NT ? SEQ : CL;
        const bf16_t* src = (const bf16_t*)(p.ws + (isq ? WS_QM : WS_KM)); const int t = row0 + i - seq0;
#pragma unroll
        for (int half = 0; half < 2; ++half) { const int d0 = ((tid & 7) + half * 8) * 8;
#pragma unroll
            for (int j = 0; j < 5; ++j) { const int tt = t + j - 2; W[half * 5 + j] = (u32x4){0u, 0u, 0u, 0u};
                if (tt >= 0 && tt < seqlen) W[half * 5 + j] = *(const u32x4*)(src + (size_t)(seq0 + tt) * 1024 + h * 128 + d0); } }
    };
    auto compute_item = [&](int item, const u32x4 (&W)[10]) {
        const bool isq = item >= NKI; const int it = isq ? item - NKI : item; const int h = it & 7, row0 = (it >> 3) * 64;
        bf16_t* dst = (bf16_t*)(p.ws + (isq ? WS_QC : WS_KC));
        const float* cw = p.conv_w + (isq ? 0 : 1024) + h * 128; const float* cb = p.conv_b + (isq ? 0 : 1024) + h * 128;
        const float sc = isq ? 0.08838834764831845f : 1.0f;
        f32x4 cwv[2][6][2];
#pragma unroll
        for (int half = 0; half < 2; ++half) { const int d0 = ((tid & 7) + half * 8) * 8;
#pragma unroll
            for (int j = 0; j < 5; ++j) { cwv[half][j][0] = *(const f32x4*)(cw + j * 2048 + d0); cwv[half][j][1] = *(const f32x4*)(cw + j * 2048 + d0 + 4); }
            cwv[half][5][0] = *(const f32x4*)(cb + d0); cwv[half][5][1] = *(const f32x4*)(cb + d0 + 4); }
#pragma unroll
        for (int half = 0; half < 2; ++half) { const int d0 = ((tid & 7) + half * 8) * 8;
            f32x4 a0 = cwv[half][5][0], a1 = cwv[half][5][1];
#pragma unroll
            for (int j = 0; j < 5; ++j) { const u32x4 w = W[half * 5 + j];
                const f32x4 c0 = cwv[half][j][0], c1 = cwv[half][j][1];
                a0 += c0 * (f32x4){bflo(w.x), bfhi(w.x), bflo(w.y), bfhi(w.y)}; a1 += c1 * (f32x4){bflo(w.z), bfhi(w.z), bflo(w.w), bfhi(w.w)}; }
#pragma unroll
            for (int e = 0; e < 4; ++e) { a0[e] = a0[e] * __builtin_amdgcn_rcpf(1.0f + __expf(-a0[e])) * sc; a1[e] = a1[e] * __builtin_amdgcn_rcpf(1.0f + __expf(-a1[e])) * sc; }
            u32x4 o; o.x = cvt_pk_bf16(a0[0], a0[1]); o.y = cvt_pk_bf16(a0[2], a0[3]); o.z = cvt_pk_bf16(a1[0], a1[1]); o.w = cvt_pk_bf16(a1[2], a1[3]);
            *(u32x4*)(dst + (size_t)(row0 + i) * 1024 + h * 128 + d0) = o; }
    };
    u32x4 Wa[10], Wb[10];
    int item = blockIdx.x;
    if (item < NI) load_item(item, Wa);
    for (; item < NI; item += 2 * G) {
        if (item + G < NI) load_item(item + G, Wb);
        compute_item(item, Wa);
        if (item + G < NI) { if (item + 2 * G < NI) load_item(item + 2 * G, Wa); compute_item(item + G, Wb); }
    }
}

__device__ void phase_mlstm(const Params& p, unsigned char* smem) {
    const int tid = threadIdx.x, G = gridDim.x, lane = tid & 63, wid = __builtin_amdgcn_readfirstlane(tid >> 6), r32 = lane & 31, hi = lane >> 5;
    float* F = (float*)(smem + OFF_F);
    const bf16_t* KC = (const bf16_t*)(p.ws + WS_KC); const bf16_t* VM = (const bf16_t*)(p.ws + WS_VM); const bf16_t* QC = (const bf16_t*)(p.ws + WS_QC);
    const float* KRGT = (const float*)(p.ws + WS_KRGT);
    for (int it0 = blockIdx.x; it0 < 256; it0 += G) {
        const int item = (G == 256) ? (((it0 & 7) + 8 * (it0 >> 6)) << 3) + ((it0 >> 3) & 7) : it0;
        const int sl = item & 3, dir = (item >> 2) & 1, h = (item >> 3) & 7, b = item >> 6;
        bf16_t* HX = (bf16_t*)(p.ws + (dir ? WS_HB : WS_HF));
        if (tid < 128) F[F_N + tid] = 0.f;
        for (int i = tid; i < 64 * CTS / 2; i += NTHR) ((unsigned*)(smem + OFF_CT))[i] = 0u;
        f32x16 Cst; for (int r = 0; r < 16; ++r) Cst[r] = 0.f;
        float m_prev = -1e30f;
        const float gbi = p.gate_b[(2 * dir) * 8 + h], gbf = p.gate_b[(2 * dir + 1) * 8 + h];
        __syncthreads();
        u32x4 pk0, pk1, pq0, pq1, pv; float pgi, pgf;
#define ML_CHUNK(stx, isctx_, tokbase_, rowbase_) const bool isctx_ = (stx) < 4; const int tokbase_ = (isctx_ ? (dir ? 3 - (stx) : (stx)) : (dir ? 67 - (stx) : (stx) - 4)) * 64, rowbase_ = isctx_ ? NT + b * CL : b * SEQ
#define ML_LBAR() do { asm volatile("s_waitcnt lgkmcnt(0)" ::: "memory"); __builtin_amdgcn_s_barrier(); asm volatile("" ::: "memory"); } while (0)
#define ML_LOAD(stx) do { ML_CHUNK(stx, ic_, tb_, rb_); \
            { const int i0 = tid & 31, c0 = (tid >> 5) * 8; const size_t r0 = (size_t)(rb_ + tb_ + (dir ? 63 - i0 : i0)) * 1024 + h * 128 + c0, r1 = (size_t)(rb_ + tb_ + (dir ? 31 - i0 : 32 + i0)) * 1024 + h * 128 + c0; \
              pk0 = *(const u32x4*)(KC + r0); pk1 = *(const u32x4*)(KC + r1); if (!ic_) { pq0 = *(const u32x4*)(QC + r0); pq1 = *(const u32x4*)(QC + r1); } } \
            { const int iv = tid & 63; pv = *(const u32x4*)(VM + (size_t)(rb_ + tb_ + (dir ? 63 - iv : iv)) * 2048 + h * 256 + sl * 64 + (tid >> 6) * 8); } \
            { const float* gp = KRGT + (size_t)(rb_ + tb_ + (dir ? 63 - lane : lane)) * 96 + 64 + h; pgi = gp[(2 * dir) * 8]; pgf = gp[(2 * dir + 1) * 8]; } } while (0)
#define ML_SCAN(bi) do { float* FB_ = F + 640 + (bi) * 384; \
            const float gi = pgi + gbi, gf = pgf + gbf; \
            const float lf = fminf(gf, 0.f) - __logf(1.0f + __expf(-fabsf(gf))); \
            const float bc = scan_add64(lf); \
            const float a_ = gi - bc; const float pm = scan_max64(a_); \
            const float btot = __int_as_float(__builtin_amdgcn_readlane(__float_as_int(bc), 63)); \
            const float mrow = bc + fmaxf(m_prev, pm); \
            const float wsraw = btot + a_; const float wmax = btot + __int_as_float(__builtin_amdgcn_readlane(__float_as_int(pm), 63)); \
            const float m_new = fmaxf(btot + m_prev, wmax); \
            FB_[lane] = bc - mrow; FB_[64 + lane] = a_; FB_[128 + lane] = __expf(bc + m_prev - mrow); FB_[192 + lane] = __expf(-mrow); { const float wsv_ = __expf(wsraw - m_new); FB_[256 + lane] = wsv_; ((bf16_t*)(FB_ + 324))[lane] = (bf16_t)(cvt_pk_bf16(wsv_, 0.f) & 0xffff); } \
            if (lane == 0) FB_[320] = __expf(btot + m_prev - m_new); \
            m_prev = m_new; } while (0)
        ML_LOAD(0);
        if (wid == 3) ML_SCAN(0);
        __syncthreads();
        for (int st = 0; st < 68; ++st) {
            ML_CHUNK(st, isctx, tokbase, rowbase);
            const float* FBc = F + 640 + (st & 1) * 384; const float decay = FBc[320];
            {
                const int i0 = tid & 31, c0 = (tid >> 5) * 8;
                *(u32x4*)(smem + OFF_K + (i0 * QS + c0) * 2) = pk0; *(u32x4*)(smem + OFF_K + ((32 + i0) * QS + c0) * 2) = pk1;
                bf16_t* kt = (bf16_t*)(smem + OFF_KT) + c0 * KTS + i0;
                kt[0] = (bf16_t)(pk0.x & 0xffff); kt[KTS] = (bf16_t)(pk0.x >> 16); kt[2 * KTS] = (bf16_t)(pk0.y & 0xffff); kt[3 * KTS] = (bf16_t)(pk0.y >> 16);
                kt[4 * KTS] = (bf16_t)(pk0.z & 0xffff); kt[5 * KTS] = (bf16_t)(pk0.z >> 16); kt[6 * KTS] = (bf16_t)(pk0.w & 0xffff); kt[7 * KTS] = (bf16_t)(pk0.w >> 16);
                kt += 32;
                kt[0] = (bf16_t)(pk1.x & 0xffff); kt[KTS] = (bf16_t)(pk1.x >> 16); kt[2 * KTS] = (bf16_t)(pk1.y & 0xffff); kt[3 * KTS] = (bf16_t)(pk1.y >> 16);
                kt[4 * KTS] = (bf16_t)(pk1.z & 0xffff); kt[5 * KTS] = (bf16_t)(pk1.z >> 16); kt[6 * KTS] = (bf16_t)(pk1.w & 0xffff); kt[7 * KTS] = (bf16_t)(pk1.w >> 16);
                if (!isctx) { *(u32x4*)(smem + OFF_Q + (i0 * QS + c0) * 2) = pq0; *(u32x4*)(smem + OFF_Q + ((32 + i0) * QS + c0) * 2) = pq1; }
                const int i = tid & 63, cg8 = (tid >> 6) * 8; const float wsi = FBc[256 + i];
                const float vv[8] = {bflo(pv.x), bfhi(pv.x), bflo(pv.y), bfhi(pv.y), bflo(pv.z), bfhi(pv.z), bflo(pv.w), bfhi(pv.w)};
                bf16_t* vt = (bf16_t*)(smem + OFF_VT) + cg8 * KTS + i; bf16_t* vwt = (bf16_t*)(smem + OFF_VWT) + cg8 * KTS + i;
                vt[0] = (bf16_t)(pv.x & 0xffff); vt[KTS] = (bf16_t)(pv.x >> 16); vt[2 * KTS] = (bf16_t)(pv.y & 0xffff); vt[3 * KTS] = (bf16_t)(pv.y >> 16);
                vt[4 * KTS] = (bf16_t)(pv.z & 0xffff); vt[5 * KTS] = (bf16_t)(pv.z >> 16); vt[6 * KTS] = (bf16_t)(pv.w & 0xffff); vt[7 * KTS] = (bf16_t)(pv.w >> 16);
#pragma unroll
                for (int e = 0; e < 8; e += 2) { const unsigned pw = cvt_pk_bf16(vv[e] * wsi, vv[e + 1] * wsi); vwt[e * KTS] = (bf16_t)(pw & 0xffff); vwt[(e + 1) * KTS] = (bf16_t)(pw >> 16); }
            }
            if (st + 1 < 68) ML_LOAD(st + 1);
            ML_LBAR();
            f32x16 accQC; for (int r = 0; r < 16; ++r) accQC[r] = 0.f;
            if (!isctx) {
                { const int i = tid >> 3, part = tid & 7; const u32x4 q0 = *(const u32x4*)(smem + OFF_Q + (i * QS + part * 16) * 2), q1 = *(const u32x4*)(smem + OFF_Q + (i * QS + part * 16 + 8) * 2);
                  const float* nn = F + F_N + part * 16;
                  float s = bflo(q0.x) * nn[0] + bfhi(q0.x) * nn[1] + bflo(q0.y) * nn[2] + bfhi(q0.y) * nn[3] + bflo(q0.z) * nn[4] + bfhi(q0.z) * nn[5] + bflo(q0.w) * nn[6] + bfhi(q0.w) * nn[7]
                          + bflo(q1.x) * nn[8] + bfhi(q1.x) * nn[9] + bflo(q1.y) * nn[10] + bfhi(q1.y) * nn[11] + bflo(q1.z) * nn[12] + bfhi(q1.z) * nn[13] + bflo(q1.w) * nn[14] + bfhi(q1.w) * nn[15];
                  s += __shfl_xor(s, 1); s += __shfl_xor(s, 2); s += __shfl_xor(s, 4);
                  if (part == 0) F[F_QN + i] = s; }
                if (wid < 4) {
                    const int stile = wid & 1, ttile = wid >> 1; const int t = 32 * ttile + r32;
                    f32x16 acc; for (int r = 0; r < 16; ++r) acc[r] = 0.f;
                    float vals[16]; float psum = 0.f;
                    if (!(stile == 1 && ttile == 0)) {
#pragma unroll 2
                        for (int kk = 0; kk < 8; ++kk) acc = __builtin_amdgcn_mfma_f32_32x32x16_bf16(ldfrag(smem + OFF_K, 32 * stile + r32, QS, kk * 16 + hi * 8), ldfrag(smem + OFF_Q, t, QS, kk * 16 + hi * 8), acc, 0, 0, 0);
                        const float rc = FBc[t];
#pragma unroll
                        for (int r = 0; r < 16; ++r) { const int s = 32 * stile + crow(r, hi); const float e = __expf(fminf(rc + FBc[64 + s], 0.f)); vals[r] = s <= t ? acc[r] * e : 0.f; psum += vals[r]; }
                    } else {
#pragma unroll
                        for (int r = 0; r < 16; ++r) vals[r] = 0.f;
                    }
                    psum += __shfl_xor(psum, 32);
                    if (hi == 0) F[F_PSUM + stile * 64 + t] = psum;
#pragma unroll
                    for (int g4 = 0; g4 < 4; ++g4) { u32x2 w; w.x = cvt_pk_bf16(vals[4 * g4], vals[4 * g4 + 1]); w.y = cvt_pk_bf16(vals[4 * g4 + 2], vals[4 * g4 + 3]);
                        *(u32x2*)(smem + OFF_P + (t * KTS + 32 * stile + 8 * g4 + 4 * hi) * 2) = w; }
                } else {
                    const int w4 = wid - 4, ttile = w4 & 1, ctile = w4 >> 1;
#pragma unroll 2
                    for (int kk = 0; kk < 8; ++kk) accQC = __builtin_amdgcn_mfma_f32_32x32x16_bf16(ldfrag(smem + OFF_Q, 32 * ttile + r32, QS, kk * 16 + hi * 8), ldfrag(smem + OFF_CT, 32 * ctile + r32, CTS, kk * 16 + hi * 8), accQC, 0, 0, 0);
                }
            }
            ML_LBAR();
            if (!isctx && wid >= 4) {
                const int w4 = wid - 4, ttile = w4 & 1, ctile = w4 >> 1;
                f32x16 accPV; for (int r = 0; r < 16; ++r) accPV[r] = 0.f;
#pragma unroll
                for (int kk = 0; kk < 4; ++kk) accPV = __builtin_amdgcn_mfma_f32_32x32x16_bf16(ldfrag(smem + OFF_P, 32 * ttile + r32, KTS, kk * 16 + hi * 8), ldfrag(smem + OFF_VT, 32 * ctile + r32, KTS, kk * 16 + hi * 8), accPV, 0, 0, 0);
                const int c = 32 * ctile + r32;
                float inv[16], sig[16];
#pragma unroll
                for (int r = 0; r < 16; ++r) { const int t = 32 * ttile + crow(r, hi); const float si = FBc[128 + t];
                    const float den = F[F_PSUM + t] + F[F_PSUM + 64 + t] + si * F[F_QN + t];
                    inv[r] = __builtin_amdgcn_rcpf(fmaxf(fabsf(den), FBc[192 + t])); sig[r] = si; }
#pragma unroll
                for (int r = 0; r < 16; ++r) { const int t = 32 * ttile + crow(r, hi); const float hv = (accPV[r] + sig[r] * accQC[r]) * inv[r];
                    const int tok = tokbase + (dir ? 63 - t : t);
                    HX[(size_t)(b * SEQ + tok) * 2048 + h * 256 + sl * 64 + c] = (bf16_t)(cvt_pk_bf16(hv, 0.f) & 0xffff); }
            }
            {
                const int dtile = wid & 3, ctile = wid >> 2;
#pragma unroll
                for (int r = 0; r < 16; ++r) Cst[r] *= decay;
#pragma unroll
                for (int kk = 0; kk < 4; ++kk) Cst = __builtin_amdgcn_mfma_f32_32x32x16_bf16(ldfrag(smem + OFF_KT, 32 * dtile + r32, KTS, kk * 16 + hi * 8), ldfrag(smem + OFF_VWT, 32 * ctile + r32, KTS, kk * 16 + hi * 8), Cst, 0, 0, 0);
#pragma unroll
                for (int g4 = 0; g4 < 4; ++g4) { u32x2 w; w.x = cvt_pk_bf16(Cst[4 * g4], Cst[4 * g4 + 1]); w.y = cvt_pk_bf16(Cst[4 * g4 + 2], Cst[4 * g4 + 3]);
                    *(u32x2*)(smem + OFF_CT + ((32 * ctile + r32) * CTS + 32 * dtile + 8 * g4 + 4 * hi) * 2) = w; }
            }
            if (wid < 4) {
                f32x16 accN; for (int r = 0; r < 16; ++r) accN[r] = 0.f;
                const bf16_t* wsb = (const bf16_t*)(FBc + 324);
#pragma unroll
                for (int kk = 0; kk < 4; ++kk) { bf16x8 af = *(const bf16x8*)(wsb + kk * 16 + hi * 8); if (r32 != 0) af = (bf16x8){0, 0, 0, 0, 0, 0, 0, 0};
                    accN = __builtin_amdgcn_mfma_f32_32x32x16_bf16(af, ldfrag(smem + OFF_KT, 32 * wid + r32, KTS, kk * 16 + hi * 8), accN, 0, 0, 0); }
                if (hi == 0) F[F_N + 32 * wid + r32] = decay * F[F_N + 32 * wid + r32] + accN[0];
            }
            if (wid == 3 && st + 1 < 68) ML_SCAN((st + 1) & 1);
            ML_LBAR();
        }
    }
}
}
__device__ __forceinline__ void rope_pair(float& val, int i  , int tpos) {
    const int ax = i >> 5, half = (i >> 4) & 1, f = i & 15;
    const float partner = __shfl_xor(val, 16);
    const float pos = (float)(ax == 0 ? (tpos >> 6) : (tpos & 63));
    const float freq = exp2f(-(float)f * (13.287712379549449f / 16.0f));
    const float ang = pos * freq, rev = ang * 0.15915494309189535f;
    const float sn = __builtin_amdgcn_sinf(rev), cs = __builtin_amdgcn_cosf(rev);
    const float x1 = half ? partner : val, x2 = half ? val : partner;
    val = half ? (x1 * sn + x2 * cs) : (x1 * cs - x2 * sn);
}

__device__ __forceinline__ void rope8(float (&v)[8], int sub, int tpos, bool apply) {
    const int ax = (sub >> 2) & 1, half = (sub >> 1) & 1; const float pos = (float)(ax == 0 ? (tpos >> 6) : (tpos & 63));
#pragma unroll
    for (int e = 0; e < 8; ++e) {
        const float partner = __shfl_xor(v[e], 2);
        const float freq = exp2f(-(float)((sub & 1) * 8 + e) * (13.287712379549449f / 16.0f));
        const float rev = pos * freq * 0.15915494309189535f;
        const float sn = __builtin_amdgcn_sinf(rev), cs = __builtin_amdgcn_cosf(rev);
        const float x1 = half ? partner : v[e], x2 = half ? v[e] : partner;
        const float r = half ? (x1 * sn + x2 * cs) : (x1 * cs - x2 * sn);
        if (apply && sub >= 16) v[e] = r;
    }
}
__device__ __forceinline__ float half_sum(float v) { for (int o = 16; o >= 1; o >>= 1) v += __shfl_xor(v, o); return v; }
__device__ void phase_elem(const Params& p) {
    const int tid = threadIdx.x, G = gridDim.x, lane = tid & 63, wid = tid >> 6;
    {
        const bf16_t* HF = (const bf16_t*)(p.ws + WS_HF); const bf16_t* HB = (const bf16_t*)(p.ws + WS_HB); bf16_t* GZ = (bf16_t*)(p.ws + WS_GMZ);
        const f32x4 g = *(const f32x4*)(p.mh_norm_g + tid * 4);
        for (int row0 = blockIdx.x; row0 < NT; row0 += 4 * G) {
            u32x2 av[4], bv[4], zv[4];
#pragma unroll
            for (int u = 0; u < 4; ++u) { const int row = row0 + u * G; if (row < NT) { const size_t off = (size_t)row * 2048 + tid * 4; av[u] = *(const u32x2*)(HF + off); bv[u] = *(const u32x2*)(HB + off); zv[u] = *(const u32x2*)(GZ + off); } }
#pragma unroll
            for (int u = 0; u < 4; ++u) { const int row = row0 + u * G; if (row < NT) { const size_t off = (size_t)row * 2048 + tid * 4; const u32x2 a = av[u], b = bv[u], z = zv[u];
                const f32x4 s = (f32x4){bflo(a.x) + bflo(b.x), bfhi(a.x) + bfhi(b.x), bflo(a.y) + bflo(b.y), bfhi(a.y) + bfhi(b.y)};
                const float ss = wave_sum(s[0] * s[0] + s[1] * s[1] + s[2] * s[2] + s[3] * s[3]);
                const float rstd = rsqrtf(ss * (1.0f / 256.0f) + EPS);
                const f32x4 y = s * rstd * g * (f32x4){bflo(z.x), bfhi(z.x), bflo(z.y), bfhi(z.y)};
                u32x2 w; w.x = cvt_pk_bf16(y[0], y[1]); w.y = cvt_pk_bf16(y[2], y[3]);
                *(u32x2*)(GZ + off) = w; } }
        }
    }
    {
        bf16_t* QA = (bf16_t*)(p.ws + WS_QA); const int sub = lane & 31, subc = sub < 24 ? sub : 23;
        const f32x4 ga = *(const f32x4*)(p.q_norm_g + subc * 8), gb = *(const f32x4*)(p.q_norm_g + subc * 8 + 4);
        for (int it0 = (blockIdx.x * 8 + wid) * 2 + (lane >> 5); it0 < NT * 16; it0 += 4 * G * 16) {
            u32x4 wv[4];
#pragma unroll
            for (int u = 0; u < 4; ++u) { const int it = it0 + u * G * 16; if (it < NT * 16) wv[u] = *(const u32x4*)(QA + (size_t)(it >> 4) * 3072 + (it & 15) * 192 + subc * 8); }
#pragma unroll
            for (int u = 0; u < 4; ++u) { const int it = it0 + u * G * 16; if (it < NT * 16) {
                const int row = it >> 4, hd = it & 15; u32x4* qp = (u32x4*)(QA + (size_t)row * 3072 + hd * 192 + subc * 8);
                const u32x4 w = wv[u];
                float v[8] = {bflo(w.x), bfhi(w.x), bflo(w.y), bfhi(w.y), bflo(w.z), bfhi(w.z), bflo(w.w), bfhi(w.w)};
                float ss = 0.f;
#pragma unroll
                for (int e2 = 0; e2 < 8; ++e2) ss += v[e2] * v[e2];
                const float rstd = rsqrtf(half_sum(sub < 24 ? ss : 0.f) * (1.0f / 192.0f) + EPS);
#pragma unroll
                for (int e2 = 0; e2 < 4; ++e2) { v[e2] *= rstd * ga[e2]; v[4 + e2] *= rstd * gb[e2]; }
                rope8(v, sub, row & 4095, true);
#pragma unroll
                for (int e2 = 0; e2 < 8; ++e2) v[e2] *= 0.10411754627145016f;
                u32x4 o; o.x = cvt_pk_bf16(v[0], v[1]); o.y = cvt_pk_bf16(v[2], v[3]); o.z = cvt_pk_bf16(v[4], v[5]); o.w = cvt_pk_bf16(v[6], v[7]);
                if (sub < 24) *qp = o; } }
        }
    }
    {
        bf16_t* CK = (bf16_t*)(p.ws + WS_CKV);
        const f32x4 ga = *(const f32x4*)(p.kv_norm_g + lane * 8), gb = *(const f32x4*)(p.kv_norm_g + lane * 8 + 4);
        for (int row0 = blockIdx.x * 8 + wid; row0 < NR; row0 += 4 * G * 8) {
            u32x4 wv[4];
#pragma unroll
            for (int u = 0; u < 4; ++u) { const int row = row0 + u * G * 8; if (row < NR) wv[u] = *(const u32x4*)(CK + (size_t)row * 512 + lane * 8); }
#pragma unroll
            for (int u = 0; u < 4; ++u) { const int row = row0 + u * G * 8; if (row < NR) {
                u32x4* pp = (u32x4*)(CK + (size_t)row * 512 + lane * 8); const u32x4 w = wv[u];
                f32x4 a = (f32x4){bflo(w.x), bfhi(w.x), bflo(w.y), bfhi(w.y)}, b = (f32x4){bflo(w.z), bfhi(w.z), bflo(w.w), bfhi(w.w)};
                const float rstd = rsqrtf(wave_sum(a[0] * a[0] + a[1] * a[1] + a[2] * a[2] + a[3] * a[3] + b[0] * b[0] + b[1] * b[1] + b[2] * b[2] + b[3] * b[3]) * (1.0f / 512.0f) + EPS);
                a = a * rstd * ga; b = b * rstd * gb;
                u32x4 o; o.x = cvt_pk_bf16(a[0], a[1]); o.y = cvt_pk_bf16(a[2], a[3]); o.z = cvt_pk_bf16(b[0], b[1]); o.w = cvt_pk_bf16(b[2], b[3]);
                *pp = o; } }
        }
    }
}
__device__ void phase_kfin(const Params& p) {
    const int tid = threadIdx.x, G = gridDim.x, lane = tid & 63, wid = tid >> 6;
    bf16_t* KB = (bf16_t*)(p.ws + WS_KB); const float* KRGT = (const float*)(p.ws + WS_KRGT);
    const int sub = lane & 31, subc = sub < 24 ? sub : 23;
    const f32x4 ga = *(const f32x4*)(p.k_norm_g + subc * 8), gb = *(const f32x4*)(p.k_norm_g + subc * 8 + 4);
    for (int it0 = (blockIdx.x * 8 + wid) * 2 + (lane >> 5); it0 < NR * 16; it0 += 8 * G * 16) {
        f32x4 la[8], lb[8];
#pragma unroll
        for (int u = 0; u < 8; ++u) lb[u] = (f32x4){0.f, 0.f, 0.f, 0.f};
#pragma unroll
        for (int u = 0; u < 8; ++u) { const int it = it0 + u * G * 16; if (it < NR * 16) {
            const int orow = it >> 4, hd = it & 15; const int b = orow / SKV, j = orow - b * SKV; const int grow = j < CL ? NT + b * CL + j : b * SEQ + (j - CL);
            if (sub < 16) { const u32x4 w = *(const u32x4*)(KB + (size_t)orow * 3072 + hd * 192 + subc * 8); la[u] = __builtin_bit_cast(f32x4, w); }
            else { const float* kr = KRGT + (size_t)grow * 96 + (subc - 16) * 8; la[u] = *(const f32x4*)kr; lb[u] = *(const f32x4*)(kr + 4); } } }
#pragma unroll
        for (int u = 0; u < 8; ++u) { const int it = it0 + u * G * 16; if (it < NR * 16) {
            const int orow = it >> 4, hd = it & 15; const int b = orow / SKV, j = orow - b * SKV; const bool isctx = j < CL;
            u32x4* kp = (u32x4*)(KB + (size_t)orow * 3072 + hd * 192 + subc * 8);
            float v[8] = {la[u][0], la[u][1], la[u][2], la[u][3], lb[u][0], lb[u][1], lb[u][2], lb[u][3]};
            if (sub < 16) { const u32x4 w = __builtin_bit_cast(u32x4, la[u]); v[0] = bflo(w.x); v[1] = bfhi(w.x); v[2] = bflo(w.y); v[3] = bfhi(w.y); v[4] = bflo(w.z); v[5] = bfhi(w.z); v[6] = bflo(w.w); v[7] = bfhi(w.w); }
            float ss = 0.f;
#pragma unroll
            for (int e2 = 0; e2 < 8; ++e2) ss += v[e2] * v[e2];
            const float rstd = rsqrtf(half_sum(sub < 24 ? ss : 0.f) * (1.0f / 192.0f) + EPS);
#pragma unroll
            for (int e2 = 0; e2 < 4; ++e2) { v[e2] *= rstd * ga[e2]; v[4 + e2] *= rstd * gb[e2]; }
            rope8(v, sub, j - CL, !isctx);
            u32x4 o; o.x = cvt_pk_bf16(v[0], v[1]); o.y = cvt_pk_bf16(v[2], v[3]); o.z = cvt_pk_bf16(v[4], v[5]); o.w = cvt_pk_bf16(v[6], v[7]);
            if (sub < 24) *kp = o; } }
    }
}
namespace att {
constexpr int DQ = 192, NW = 8, QBLK = 32, KVBLK = 64;
constexpr float SCALE = 0.07216878364870322f;
constexpr float THR = 8.f;
constexpr int LDQ = 3072, LDK = 3072, LDV = 2048, LDO = 2048;
constexpr int SDEPTH = 1;
constexpr int SHM_V = KVBLK * 128 * 2, SHM_K = KVBLK * DQ * 2, SHM_ATTN = 3 * SHM_V + 3 * SHM_K + NW * 64 * 4;
#define KSWZ(row, colB) ((row) * 384 + ((colB) ^ (((row) & 7) << 4)))
#define SBAR() __builtin_amdgcn_sched_barrier(0)
__device__ __forceinline__ int crow(int r, int hi) { return (r & 3) + 8 * (r >> 2) + 4 * hi; }
__device__ __forceinline__ void softmaxP(f32x16& p0, f32x16& p1, float& l_reg, bf16x8& pa0, bf16x8& pa1, bf16x8& pa2, bf16x8& pa3) {
  for (int r = 0; r < 16; ++r) p0[r] = __builtin_amdgcn_exp2f(p0[r]);
  for (int r = 0; r < 16; ++r) p1[r] = __builtin_amdgcn_exp2f(p1[r]);
  float ps = 0; for (int r = 0; r < 16; ++r) ps += p0[r]; for (int r = 0; r < 16; ++r) ps += p1[r];
  { auto rr = __builtin_amdgcn_permlane32_swap(__float_as_uint(ps), __float_as_uint(ps), false, false);
    ps = __uint_as_float(rr[0]) + __uint_as_float(rr[1]); }
  l_reg += ps;
#define PK4(P, BASE, OUT) do { unsigned a0 = cvt_pk_bf16(P[BASE + 0], P[BASE + 1]), a1 = cvt_pk_bf16(P[BASE + 2], P[BASE + 3]);   \
    unsigned b0 = cvt_pk_bf16(P[BASE + 4], P[BASE + 5]), b1 = cvt_pk_bf16(P[BASE + 6], P[BASE + 7]);                              \
    auto r0 = __builtin_amdgcn_permlane32_swap(a0, b0, false, false); auto r1 = __builtin_amdgcn_permlane32_swap(a1, b1, false, false); \
    u32x4 w = {r0[0], r1[0], r0[1], r1[1]}; OUT = *reinterpret_cast<bf16x8*>(&w); } while (0)
  PK4(p0, 0, pa0); PK4(p0, 8, pa1); PK4(p1, 0, pa2); PK4(p1, 8, pa3);
#undef PK4
}
__device__ __forceinline__ void qkt(f32x16& p0, f32x16& p1, const char* Ks, const bf16x8* qr, const char* qrl, int r32, int hi) {
  for (int r = 0; r < 16; ++r) { p0[r] = 0.f; p1[r] = 0.f; }
#pragma unroll
  for (int d0 = 0; d0 < 12; ++d0) { int cb = (d0 * 16 + hi * 8) * 2;
    bf16x8 b0 = *reinterpret_cast<const bf16x8*>(Ks + KSWZ(r32, cb));
    bf16x8 b1 = *reinterpret_cast<const bf16x8*>(Ks + KSWZ(32 + r32, cb));
    const bf16x8 qf = d0 < 10 ? qr[d0] : *reinterpret_cast<const bf16x8*>(qrl + (d0 - 10) * 1024);
    p0 = __builtin_amdgcn_mfma_f32_32x32x16_bf16(b0, qf, p0, 0, 0, 0);
    p1 = __builtin_amdgcn_mfma_f32_32x32x16_bf16(b1, qf, p1, 0, 0, 0); }
}
__device__ __forceinline__ int v_st(int k, int c) { const int kk = (k & ~0xC) | ((k & 4) << 1) | ((k & 8) >> 1); return ((kk >> 3) * 4 + (c >> 5)) * 512 + ((kk & 7) * 32 + (c & 31)) * 2; }
__device__ __forceinline__ int v_rd_base(int lane) { return ((lane & 3) << 3) | (((lane >> 2) & 3) << 6) | (((lane >> 4) & 1) << 5) | (((lane >> 5) & 1) << 8); }
constexpr int v_rd_off(int d0, int ks, int half) { return d0 * 512 + ks * 4096 + half * 2048; }
template <int OFF> __device__ __forceinline__ s16x4 tr_read(int vb) {
  s16x4 r; asm volatile("ds_read_b64_tr_b16 %0, %1 offset:%2" : "=&v"(r) : "v"(vb), "i"(OFF) : "memory"); return r;
}
template <int D0> __device__ __forceinline__ void pv_one(f32x16& od, int vb, bf16x8 pa0, bf16x8 pa1, bf16x8 pa2, bf16x8 pa3) {
  const s16x4 l0 = tr_read<v_rd_off(D0, 0, 0)>(vb), h0 = tr_read<v_rd_off(D0, 0, 1)>(vb), l1 = tr_read<v_rd_off(D0, 1, 0)>(vb), h1 = tr_read<v_rd_off(D0, 1, 1)>(vb);
  const s16x4 l2 = tr_read<v_rd_off(D0, 2, 0)>(vb), h2 = tr_read<v_rd_off(D0, 2, 1)>(vb), l3 = tr_read<v_rd_off(D0, 3, 0)>(vb), h3 = tr_read<v_rd_off(D0, 3, 1)>(vb);
  asm volatile("s_waitcnt lgkmcnt(0)" ::: "memory"); SBAR();
#define PK(L, H) (bf16x8){L[0], L[1], L[2], L[3], H[0], H[1], H[2], H[3]}
  od = __builtin_amdgcn_mfma_f32_32x32x16_bf16(pa0, PK(l0, h0), od, 0, 0, 0);
  od = __builtin_amdgcn_mfma_f32_32x32x16_bf16(pa1, PK(l1, h1), od, 0, 0, 0);
  od = __builtin_amdgcn_mfma_f32_32x32x16_bf16(pa2, PK(l2, h2), od, 0, 0, 0);
  od = __builtin_amdgcn_mfma_f32_32x32x16_bf16(pa3, PK(l3, h3), od, 0, 0, 0);
#undef PK
}
__device__ __forceinline__ void pv_d0(f32x16* o, int vb, bf16x8 pa0, bf16x8 pa1, bf16x8 pa2, bf16x8 pa3) {
  pv_one<0>(o[0], vb, pa0, pa1, pa2, pa3); pv_one<1>(o[1], vb, pa0, pa1, pa2, pa3); pv_one<2>(o[2], vb, pa0, pa1, pa2, pa3); pv_one<3>(o[3], vb, pa0, pa1, pa2, pa3);
}
__device__ __forceinline__ void attn_body(const bf16_t* __restrict__ Qb, const bf16_t* __restrict__ Kh, const bf16_t* __restrict__ Vh, bf16_t* __restrict__ Ob, int seq, char* lds) {
  const int tid = threadIdx.x, wid = tid >> 6, lane = tid & 63, r32 = lane & 31, hi = lane >> 5;
  char* V_lds = lds; char* K_lds = lds + 3 * SHM_V;
  float* ws = (float*)(lds + 3 * SHM_V + 3 * SHM_K) + wid * 64; float* li_l = ws; float* al_l = ws + 32;
  float l_reg = 0; f32x16 o[4]; for (int d = 0; d < 4; ++d) for (int r = 0; r < 16; ++r) o[d][r] = 0.f;
  bf16x8 qr[10];
  const bf16_t* Qw = Qb + (long)(wid * QBLK + r32) * LDQ + hi * 8;
  char* qrl = lds + SHM_ATTN + wid * 2048 + lane * 16;
#pragma unroll
  for (int d0 = 0; d0 < 10; ++d0) qr[d0] = *reinterpret_cast<const bf16x8*>(Qw + d0 * 16);
#pragma unroll
  for (int d0 = 10; d0 < 12; ++d0) *reinterpret_cast<bf16x8*>(qrl + (d0 - 10) * 1024) = *reinterpret_cast<const bf16x8*>(Qw + d0 * 16);
  const int widu = __builtin_amdgcn_readfirstlane(wid);
  int koff[3], voff[2];
#pragma unroll
  for (int i = 0; i < 3; ++i) { const int u = (widu + 8 * i) * 64 + lane, row = u / 24, x = u % 24, c16 = x ^ (row & 7); koff[i] = row * LDK + c16 * 8; }
#pragma unroll
  for (int i = 0; i < 2; ++i) { const int u = (widu + 8 * i) * 64 + lane, sub = u >> 5, within = u & 31, kk = (sub >> 2) * 8 + (within >> 2), c = (sub & 3) * 32 + (within & 3) * 8;
    const int k = (kk & ~0xC) | ((kk & 4) << 1) | ((kk & 8) >> 1); voff[i] = k * LDV + c; }
  const LAS char* ldsl = (const LAS char*)lds;
  const int vb0 = (int)(uintptr_t)V_lds + v_rd_base(lane);
#define SDMA(b, k0) do { \
    _Pragma("unroll") for (int _i = 0; _i < 3; ++_i) __builtin_amdgcn_global_load_lds((const unsigned*)(Kh + (long)(k0) * LDK + koff[_i]), (LAS unsigned*)(ldsl + 3 * SHM_V + (b) * SHM_K + (widu + 8 * _i) * 1024), 16, 0, 0); \
    _Pragma("unroll") for (int _i = 0; _i < 2; ++_i) __builtin_amdgcn_global_load_lds((const unsigned*)(Vh + (long)(k0) * LDV + voff[_i]), (LAS unsigned*)(ldsl + (b) * SHM_V + (widu + 8 * _i) * 1024), 16, 0, 0); } while (0)
#define RESC(a) do { if (__any((a) < 1.f)) { if (hi == 0) al_l[r32] = (a); asm volatile("s_waitcnt lgkmcnt(0)" ::: "memory"); \
    for (int d = 0; d < 4; ++d) for (int r = 0; r < 16; ++r) o[d][r] *= al_l[crow(r, hi)]; } } while (0)
  f32x16 pA0, pA1, pB0, pB1; bf16x8 pa0, pa1, pa2, pa3; const int NTL = seq / KVBLK;
  SDMA(0, 0); SDMA(1, KVBLK); asm volatile("s_waitcnt vmcnt(0)" ::: "memory"); __syncthreads();
  qkt(pA0, pA1, K_lds, qr, qrl, r32, hi);
  int bp = 0, bc = 1, bn = 2;
  for (int j = 1; j + 1 < NTL; j += 2) {
    SDMA(bn, (j + 1) * KVBLK);
    SBAR(); qkt(pB0, pB1, K_lds + bc * SHM_K, qr, qrl, r32, hi); softmaxP(pA0, pA1, l_reg, pa0, pa1, pa2, pa3); SBAR();
    pv_d0(o, vb0 + bp * (int)SHM_V, pa0, pa1, pa2, pa3);
    asm volatile("s_waitcnt vmcnt(0)" ::: "memory"); __syncthreads();
    { const int t = bp; bp = bc; bc = bn; bn = t; }
    if (j + 2 < NTL) SDMA(bn, (j + 2) * KVBLK);
    SBAR(); qkt(pA0, pA1, K_lds + bc * SHM_K, qr, qrl, r32, hi); softmaxP(pB0, pB1, l_reg, pa0, pa1, pa2, pa3); SBAR();
    pv_d0(o, vb0 + bp * (int)SHM_V, pa0, pa1, pa2, pa3);
    asm volatile("s_waitcnt vmcnt(0)" ::: "memory"); __syncthreads();
    { const int t = bp; bp = bc; bc = bn; bn = t; }
  }
  SBAR(); qkt(pB0, pB1, K_lds + bc * SHM_K, qr, qrl, r32, hi); softmaxP(pA0, pA1, l_reg, pa0, pa1, pa2, pa3); SBAR();
  pv_d0(o, vb0 + bp * (int)SHM_V, pa0, pa1, pa2, pa3);
  softmaxP(pB0, pB1, l_reg, pa0, pa1, pa2, pa3); SBAR();
  pv_d0(o, vb0 + bc * (int)SHM_V, pa0, pa1, pa2, pa3);
  if (hi == 0) li_l[r32] = l_reg; asm volatile("s_waitcnt lgkmcnt(0)" ::: "memory");
  float rli[16];
#pragma unroll
  for (int r = 0; r < 16; ++r) rli[r] = __builtin_amdgcn_rcpf(li_l[crow(r, hi)]);
  bf16_t* Ow = Ob + (long)(wid * QBLK) * LDO;
  unsigned short zv[16][4];
#pragma unroll
  for (int r = 0; r < 16; ++r) { const int orow = crow(r, hi);
#pragma unroll
    for (int d0 = 0; d0 < 4; ++d0) zv[r][d0] = Ow[(long)orow * LDO + d0 * 32 + r32]; }
#pragma unroll
  for (int r = 0; r < 16; ++r) { const int orow = crow(r, hi);
#pragma unroll
    for (int d0 = 0; d0 < 4; ++d0) Ow[(long)orow * LDO + d0 * 32 + r32] = (bf16_t)(cvt_pk_bf16(o[d0][r] * rli[r] * bf2f(zv[r][d0]), 0.f) & 0xffff); }
  __syncthreads();
#undef SDMA
#undef RESC
}
template <int SCR> __device__ void phase_attn(const Params& p, unsigned char* smem, int nrep) {
  const int G = gridDim.x;
  const bf16_t* Q = (const bf16_t*)(p.ws + WS_QA); const bf16_t* K = (const bf16_t*)(p.ws + WS_KB); const bf16_t* V = (const bf16_t*)(p.ws + WS_V2); bf16_t* O = (bf16_t*)(p.ws + (SCR ? WS_U : WS_ZA));
  for (int item = blockIdx.x; item < 1024; item += G) {
    const int b = item >> 8, c = item & 255, xcd = c & 7, jj = c >> 3, h = 2 * xcd + (jj >> 4), qb = jj & 15;
    for (int rep = 0; rep < nrep; ++rep)
    attn_body(Q + ((size_t)b * SEQ + qb * 256) * LDQ + h * DQ, K + (size_t)b * SKV * LDK + h * DQ, V + (size_t)b * SKV * LDV + h * 128, (rep + 1 == nrep ? O : (bf16_t*)(p.ws + WS_U)) + ((size_t)b * SEQ + qb * 256) * LDO + h * 128, SKV, (char*)smem);
  }
}
}
constexpr int N_PHASES = 12;
#define XB_TMO      128
#define XB_XCNT(j)  (256  + 64 * (j))
#define XB_XSUB(j)  (1280 + 64 * (j))
#define XB_XGEN(j)  (2304 + 64 * (j))
#define XB_TOP      3328
#define XB_TOPGEN   3392
#define XCD_BAR_WORDS 3456
#define XB_SPIN_CAP (1u << 22)
__device__ __forceinline__ unsigned xb_ld(unsigned* p)              { return __hip_atomic_load(p, __ATOMIC_RELAXED, __HIP_MEMORY_SCOPE_AGENT); }
__device__ __forceinline__ unsigned xb_add(unsigned* p, unsigned v) { return __hip_atomic_fetch_add(p, v, __ATOMIC_RELAXED, __HIP_MEMORY_SCOPE_AGENT); }
__device__ __forceinline__ unsigned xb_xcc_id() { return (unsigned)__builtin_amdgcn_s_getreg((3 << 11) | 20) & 0xFu; }
#define XB_SPIN(cond, bar) do { unsigned _sp = 0; while (cond) { __builtin_amdgcn_s_sleep(1); \
    if ((++_sp & 255u) == 0u) { if (xb_ld(&(bar)[XB_TMO])) break; if (_sp > XB_SPIN_CAP) { atomicAdd(&(bar)[XB_TMO], 1u); break; } } } } while (0)
struct XcdBarrier { unsigned* bar; unsigned x; volatile LAS unsigned* st; };
__device__ __forceinline__ XcdBarrier xcd_barrier_post(unsigned* bar, volatile LAS unsigned* st) {
    XcdBarrier b; b.bar = bar; b.x = xb_xcc_id(); b.st = st;
    if (threadIdx.x == 0) (void)xb_add(&bar[XB_XCNT(b.x)], 1u);
    return b;
}
__device__ __forceinline__ void xcd_barrier_complete(unsigned* bar, unsigned x, unsigned& nloc, unsigned& nx) {
    const unsigned G = gridDim.x * gridDim.y * gridDim.z;
    unsigned sum, cnt, mine, sp = 0u;
    for (;;) {
        sum = 0u; cnt = 0u; mine = 0u;
#pragma unroll
        for (unsigned j = 0; j < 16; ++j) { const unsigned c = xb_ld(&bar[XB_XCNT(j)]); sum += c; cnt += (c > 0u) ? 1u : 0u; mine = (j == x) ? c : mine; }
        if (sum == G) break;
        __builtin_amdgcn_s_sleep(1);
        if ((++sp & 255u) == 0u) { if (xb_ld(&bar[XB_TMO])) break; if (sp > XB_SPIN_CAP) { atomicAdd(&bar[XB_TMO], 1u); break; } }
    }
    nloc = mine > 0u ? mine : 1u; nx = cnt > 0u ? cnt : 1u;
}
__device__ __forceinline__ void xcd_barrier(const XcdBarrier& b) {
    asm volatile("s_waitcnt vmcnt(0)" ::: "memory");
    __syncthreads();
    if (threadIdx.x == 0) {
        unsigned* bar = b.bar;
        __builtin_amdgcn_s_waitcnt(0);
        unsigned nloc = b.st[0], nx = b.st[1];
        if (nloc == 0u) { xcd_barrier_complete(bar, b.x, nloc, nx); b.st[0] = nloc; b.st[1] = nx; }
        const unsigned old = xb_add(&bar[XB_XSUB(b.x)], 1u);
        const unsigned gen = old / nloc;
        if (old + 1u == (gen + 1u) * nloc) {
            __builtin_amdgcn_fence(__ATOMIC_RELEASE, "agent");
            asm volatile("s_waitcnt vmcnt(0)" ::: "memory");
            const unsigned og = xb_add(&bar[XB_TOP], 1u);
            const unsigned tg = og / nx;
            if (og + 1u == (tg + 1u) * nx) xb_add(&bar[XB_TOPGEN], 1u);
            else XB_SPIN(xb_ld(&bar[XB_TOPGEN]) == tg, bar);
            __builtin_amdgcn_fence(__ATOMIC_ACQUIRE, "agent");
            xb_add(&bar[XB_XGEN(b.x)], 1u);
            asm volatile("s_waitcnt vmcnt(0)" ::: "memory");
        } else {
            XB_SPIN(xb_ld(&bar[XB_XGEN(b.x)]) == gen, bar);
            __builtin_amdgcn_fence(__ATOMIC_ACQUIRE, "agent");
            asm volatile("s_waitcnt vmcnt(0)" ::: "memory");
        }
    }
    __syncthreads();
}
__global__ void __launch_bounds__(NTHR) hybrid_block_fwd(Params p) {
    extern __shared__ __attribute__((aligned(16))) unsigned char smem[];
    cg::grid_group grid = cg::this_grid();
    const int lo = p.ph_lo, hi = p.ph_hi, G = gridDim.x, bid = blockIdx.x;
    LAS unsigned char* lds = (LAS unsigned char*)smem;
    volatile LAS unsigned* xst = (volatile LAS unsigned*)(lds + LDS_BYTES - 16);
    if (threadIdx.x < 4) xst[threadIdx.x] = 0u;
    __syncthreads();
    XcdBarrier xbar = xcd_barrier_post((unsigned*)(p.ws + WS_BAR), xst);
    if (hi - lo > 1) grid.sync();
    bf16_t* GM = (bf16_t*)p.out;
#ifndef PHMASK
#define PHMASK 0xFFFF
#endif
#define IN(k) (((PHMASK >> (k)) & 1) && lo <= (k) && (k) < hi)
#define SEAM(k) do { if (IN(k) && IN((k) + 1)) xcd_barrier(xbar); } while (0)
    if (IN(0)) phase_prep(p, smem);
    SEAM(0);
    if (IN(1)) phase_hrows(p, smem);
    SEAM(1);
    if (IN(2)) { pg8::Gemm g{(const bf16_t*)(p.ws + WS_H), (const bf16_t*)(p.ws + WS_WIN), 2048, LDH}; pg8::Order S; S.init(64, 71, 4, 15, G, bid); pg8::EpiG1 E{p.ws, GM}; pg8::gemm_phase(lds, g, S, E); }
    SEAM(2);
    if (IN(3)) ml::phase_conv(p);
    SEAM(3);
    if (IN(4)) ml::phase_mlstm(p, smem);
    SEAM(4);
    if (IN(5)) phase_elem(p);
    SEAM(5);
    if (IN(6)) { pg8::Gemm g{(const bf16_t*)(p.ws + WS_CKV), (const bf16_t*)(p.ws + WS_WUKV), 512, 512}; pg8::Order S; S.init(68, 16, 0, 1, G, bid); pg8::EpiG2 E{p.ws}; pg8::gemm_phase(lds, g, S, E); }
    SEAM(6);
    if (IN(7)) phase_kfin(p);
    SEAM(7);
    if (IN(8)) att::phase_attn<0>(p, smem, 1);
    SEAM(8);
    if (IN(9)) { pg8::Gemm g{(const bf16_t*)(p.ws + WS_GMZ), (const bf16_t*)(p.ws + WS_WPM), 2048, 2048}; pg8::Order S; S.init(64, 8, 0, 1, G, bid); pg8::EpiPM<0> E{(bf16_t*)(p.ws + WS_U), GM}; pg8::gemm_phase(lds, g, S, E); }
    if (IN(10)) { pg8::Gemm g{(const bf16_t*)(p.ws + WS_ZA), (const bf16_t*)(p.ws + WS_WPA), 2048, 2048}; pg8::Order S; S.init(64, 8, 0, 1, G, bid); pg8::EpiPM<1> E{(bf16_t*)(p.ws + WS_U), GM + (size_t)NT * 2048}; pg8::gemm_phase(lds, g, S, E); }
    SEAM(10);
    if (IN(11)) { pg8::Gemm g{(const bf16_t*)(p.ws + WS_U), (const bf16_t*)(p.ws + WS_WOUT), 2048, 2048}; pg8::Order S; S.init(64, 8, 0, 1, G, bid); pg8::EpiOut E{p.x, p.out, (const float*)(p.ws + WS_MOD) + 4096}; pg8::gemm_phase(lds, g, S, E); }
#undef IN
#undef SEAM
}

extern "C" void kernel_launch(void* const* d_in, const int* in_sizes, int n_in, void* d_out, int out_size, void* d_ws, size_t ws_size, hipStream_t stream) {
    static int grid = 0;
    if (grid == 0) {
        if (n_in != 20 || out_size != NT * DM || ws_size < WS_END) { fprintf(stderr, "kernel_launch: unexpected shapes (n_in %d out %d ws %zu need %zu)\n", n_in, out_size, ws_size, (size_t)WS_END); grid = -1; return; }
        int dev = 0, cus = 0, per_cu = 0;
        hipGetDevice(&dev); hipDeviceGetAttribute(&cus, hipDeviceAttributeMultiprocessorCount, dev);
        if (hipFuncSetAttribute((const void*)hybrid_block_fwd, hipFuncAttributeMaxDynamicSharedMemorySize, LDS_BYTES) != hipSuccess) { fprintf(stderr, "kernel_launch: hipFuncSetAttribute failed\n"); grid = -1; return; }
        if (hipOccupancyMaxActiveBlocksPerMultiprocessor(&per_cu, (const void*)hybrid_block_fwd, NTHR, LDS_BYTES) != hipSuccess || per_cu < 1) { fprintf(stderr, "kernel_launch: occupancy query gave %d\n", per_cu); per_cu = 1; }
        (void)hipGetLastError();
        grid = cus * per_cu;
    }
    if (grid < 0) return;
    Params p{};
    const float** f = (const float**)&p;
    for (int i = 0; i < 20; ++i) f[i] = (const float*)d_in[i];
    p.out = (float*)d_out; p.ws = (unsigned char*)d_ws;
    if (hipMemsetAsync((unsigned char*)d_ws + WS_BAR, 0, XCD_BAR_WORDS * 4, stream) != hipSuccess) { fprintf(stderr, "kernel_launch: memset failed\n"); return; }
    p.ph_lo = 0; p.ph_hi = N_PHASES;
    void* args[] = {&p};
    hipError_t e = hipLaunchCooperativeKernel((const void*)hybrid_block_fwd, dim3(grid), dim3(NTHR), args, LDS_BYTES, stream);
    if (e != hipSuccess) fprintf(stderr, "kernel_launch: cooperative launch failed: %s (grid %d)\n", hipGetErrorString(e), grid);
}
```

```cpp
#include <hip/hip_runtime.h>
#include <hip/hip_cooperative_groups.h>
#include <cstdio>
namespace cg = cooperative_groups;

#define LAS __attribute__((address_space(3)))
typedef unsigned short bf16_t;
typedef short bf16x8 __attribute__((ext_vector_type(8)));
typedef short s16x4 __attribute__((ext_vector_type(4)));
typedef float f32x4 __attribute__((ext_vector_type(4)));
typedef float f32x2 __attribute__((ext_vector_type(2)));
typedef float f32x16 __attribute__((ext_vector_type(16)));
typedef unsigned u32x4 __attribute__((ext_vector_type(4)));
typedef unsigned u32x2 __attribute__((ext_vector_type(2)));

constexpr int DM = 2048, NB = 4, SEQ = 4096, NT = NB * SEQ  , CL = 256, NC = NB * CL  , NR = NT + NC  , SKV = SEQ + CL  ;
constexpr int IN_COLS = 18016;
constexpr float EPS = 1e-6f;
constexpr int NTHR = 512;
constexpr int LDS_BYTES = 141312 + 16;

constexpr size_t al256(size_t x) { return (x + 255) / 256 * 256; }
constexpr size_t WS_MOD   = 0;
constexpr size_t WS_WUKV  = al256(WS_MOD + 5 * 6144 * 4);
constexpr size_t WS_WPM   = WS_WUKV + (size_t)4096 * 512 * 2;
constexpr size_t WS_WPA   = WS_WPM + (size_t)2048 * 2048 * 2;
constexpr size_t WS_WOUT  = WS_WPA + (size_t)2048 * 2048 * 2;
constexpr size_t WS_KM    = WS_WOUT + (size_t)2048 * 2048 * 2;
constexpr size_t WS_QM    = WS_KM + (size_t)NR * 1024 * 2;
constexpr size_t WS_VM    = WS_QM + (size_t)NT * 1024 * 2;
constexpr size_t WS_KRGT  = WS_VM + (size_t)NR * 2048 * 2;
constexpr size_t WS_CKV   = WS_KRGT + (size_t)NR * 96 * 4;
constexpr size_t WS_GMZ   = WS_CKV + (size_t)NR * 512 * 2;
constexpr size_t WS_QA    = WS_GMZ + (size_t)NT * 2048 * 2;
constexpr size_t WS_ZA    = WS_QA + (size_t)NT * 3072 * 2;
constexpr size_t WS_H     = WS_ZA + (size_t)NT * 2048 * 2;
constexpr int LDH = 2048 + 64;
constexpr size_t WS_WIN   = WS_H + (size_t)NR * LDH * 2;
constexpr size_t WS_END   = WS_WIN + (size_t)71 * 256 * LDH * 2;
constexpr size_t WS_KC    = WS_H;
constexpr size_t WS_QC    = WS_KC + (size_t)NR * 1024 * 2;
constexpr size_t WS_HF    = WS_KM;
constexpr size_t WS_HB    = WS_QC + (size_t)NT * 1024 * 2;
static_assert(WS_HF + (size_t)NT * 2048 * 2 <= WS_VM, "HF alias");
constexpr size_t WS_KB    = WS_H;
constexpr size_t WS_V2    = WS_KM;
constexpr size_t WS_U     = WS_KM + (size_t)NR * 2048 * 2;
static_assert(WS_HB + (size_t)NT * 2048 * 2 <= WS_END, "HF/HB alias");
static_assert(WS_KB + (size_t)NR * 3072 * 2 <= WS_END, "KB alias");
static_assert(WS_U + (size_t)NT * 2048 * 2 <= WS_KRGT, "U alias");
constexpr size_t WS_BAR   = WS_END;
static_assert(WS_BAR + 16384 <= 590348288ull, "workspace");

struct Params {
    const float *x, *c, *ctx, *c_ctx, *ada_w, *ada_b, *norm_g, *w_in, *conv_w, *conv_b, *gate_b, *mh_norm_g, *q_norm_g, *k_norm_g, *kv_norm_g,
                *w_uk, *w_uv, *w_proj_m, *w_proj_a, *w_out;
    float* out; unsigned char* ws; int ph_lo, ph_hi;
};

typedef __bf16 bf16x2_t __attribute__((ext_vector_type(2)));
__device__ __forceinline__ unsigned cvt_pk_bf16(float lo, float hi) { const f32x2 v = {lo, hi}; const bf16x2_t b = __builtin_convertvector(v, bf16x2_t); return __builtin_bit_cast(unsigned, b); }
__device__ __forceinline__ float bf2f(unsigned short b) { return __uint_as_float(((unsigned)b) << 16); }
__device__ __forceinline__ float bflo(unsigned w) { return __uint_as_float(w << 16); }
__device__ __forceinline__ float bfhi(unsigned w) { return __uint_as_float(w & 0xffff0000u); }
__device__ __forceinline__ float sigmoidf_(float x) { return __builtin_amdgcn_rcpf(1.0f + __expf(-x)); }
__device__ __forceinline__ float siluf_(float x) { return x * __builtin_amdgcn_rcpf(1.0f + __expf(-x)); }
__device__ __forceinline__ float wave_sum(float v) { for (int o = 32; o >= 1; o >>= 1) v += __shfl_xor(v, o); return v; }
__device__ __forceinline__ float wave_max(float v) { for (int o = 32; o >= 1; o >>= 1) v = fmaxf(v, __shfl_xor(v, o)); return v; }
namespace pg8 {
constexpr int BM = 256, BK = 64, HALF = 128, HTB = HALF * BK * 2, STAGE_BYTES = 8 * HTB, NXCD = 8, WGM = 8;
__host__ __device__ __forceinline__ int lds_byte(int r, int c) { const int st = (r >> 4) * 2 + (c >> 5), rr = r & 15, cc = c & 31, ob = rr * 64 + cc * 2; return st * 1024 + (ob ^ (((ob >> 9) & 1) << 5)); }
__host__ __device__ __forceinline__ void stage_rc(int b, int& R, int& C) { const int st = b / 1024, sb = b % 1024, swz = sb ^ (((sb >> 9) & 1) << 5); R = (st >> 1) * 16 + swz / 64; C = (st & 1) * 32 + (swz % 64) / 2; }
__host__ __device__ __forceinline__ int perm32(int rho) { const int n = rho >> 4, i = rho & 15; return 8 * (i >> 2) + 4 * n + (i & 3); }
struct Unit { int pm, pn; };
struct Gemm { const bf16_t* A; const bf16_t* Bt; int K; int ld; };
struct Order {
    int nM, nN, nwg, exN, total, G, c, wgm;
    __device__ void init(int nM_, int nN_, int exM, int exN_, int G_, int c_, int wgm_ = WGM) { nM = nM_; nN = nN_; nwg = nM * nN; exN = exN_; total = nwg + exM * exN_; G = G_; c = c_; wgm = wgm_; }
    __device__ bool next(int i, Unit& u) const {
        const long L = (long)i * G + c; if (L >= total) return false;
        if (L >= nwg) { const int idx = (int)L - nwg; u.pm = nM + idx / exN; u.pn = idx % exN; return true; }
        int wgid = (int)L; { const int q = nwg / NXCD, r = nwg % NXCD, xcd = wgid % NXCD, off = wgid / NXCD; wgid = (xcd < r ? xcd * (q + 1) : r * (q + 1) + (xcd - r) * q) + off; }
        const int nig = wgm * nN, gid = wgid / nig, fm = gid * wgm, gsz = (nM - fm) < wgm ? (nM - fm) : wgm;
        u.pm = fm + ((wgid % nig) % gsz); u.pn = (wgid % nig) / gsz; return true;
    }
};
template <class Epi>
__device__ __forceinline__ void gemm_phase(LAS unsigned char* lds, const Gemm g, const Order& S, const Epi& E) {
    const int tid = threadIdx.x, wid = __builtin_amdgcn_readfirstlane(tid >> 6), lane = tid & 63, wr = wid >> 2, wc = wid & 3, fr = lane & 15, fq = lane >> 4;
    const int K = g.K, nt = K / BK, LD = g.ld;
    unsigned voffA[2], voffB[2];
#pragma unroll
    for (int i = 0; i < 2; ++i) { int R, C; stage_rc(tid * 16 + i * 8192, R, C); const int Rb = (R & ~31) + perm32(R & 31);
        voffA[i] = (unsigned)(R * LD + C) * 2u; voffB[i] = (unsigned)(Rb * LD + C) * 2u; }
    const size_t kstep = (size_t)(BK * 2);
    const size_t hstep = (size_t)HALF * LD * 2;
    const size_t tstep = 2 * hstep;
    const unsigned ldsw = (unsigned)wid * 1024u;
    const int aoff = lds_byte(wr * 64 + fr, fq * 8), boff = lds_byte(wc * 32 + fr, fq * 8);
#define PG8_SA(b, h) (((b) * 2 + (h)) * HTB)
#define PG8_SB(b, h) ((4 + (b) * 2 + (h)) * HTB)
#define PG8_STAGE(bufoff, gbase, voff) do { _Pragma("unroll") for (int _i = 0; _i < 2; ++_i) \
        __builtin_amdgcn_global_load_lds((const unsigned*)((const char*)(gbase) + (voff)[_i]), (LAS unsigned*)(lds + (bufoff) + ldsw + _i * 8192), 16, 0, 0); } while (0)
#define PG8_LDA(dst, b, h) do { _Pragma("unroll") for (int m = 0; m < 4; ++m) _Pragma("unroll") for (int k = 0; k < 2; ++k) dst[m][k] = *(const LAS bf16x8*)(lds + PG8_SA(b, h) + aoff + m * 2048 + k * 1024); } while (0)
#define PG8_LDB(dst, b, h) do { _Pragma("unroll") for (int n = 0; n < 2; ++n) _Pragma("unroll") for (int k = 0; k < 2; ++k) dst[n][k] = *(const LAS bf16x8*)(lds + PG8_SB(b, h) + boff + n * 2048 + k * 1024); } while (0)
#define PG8_MMA(ai, bj, At, Bt) do { __builtin_amdgcn_s_setprio(1); _Pragma("unroll") for (int m = 0; m < 4; ++m) _Pragma("unroll") for (int n = 0; n < 2; ++n) _Pragma("unroll") for (int k = 0; k < 2; ++k) \
        acc[ai][bj][m][n] = __builtin_amdgcn_mfma_f32_16x16x32_bf16(Bt[n][k], At[m][k], acc[ai][bj][m][n], 0, 0, 0); __builtin_amdgcn_s_setprio(0); } while (0)
#define PG8_WAIT_V(n) asm volatile("s_waitcnt vmcnt(" #n ")" ::: "memory")
#define PG8_WAIT_L(n) asm volatile("s_waitcnt lgkmcnt(" #n ")" ::: "memory")
#define PG8_BAR __builtin_amdgcn_s_barrier()
#define PG8_SCHED __builtin_amdgcn_sched_barrier(0)
    Unit cur, nxt; int ui = 0;
    if (!S.next(0, cur)) return;
    f32x4 acc[2][2][4][2];
#pragma unroll
    for (int a = 0; a < 2; ++a)
#pragma unroll
        for (int b = 0; b < 2; ++b)
#pragma unroll
            for (int m = 0; m < 4; ++m)
#pragma unroll
                for (int n = 0; n < 2; ++n) acc[a][b][m][n] = (f32x4){0.f, 0.f, 0.f, 0.f};
    bf16x8 At[4][2], B0[2][2], B1[2][2];
    const char* cA = (const char*)g.A + (size_t)cur.pm * tstep; const char* cB = (const char*)g.Bt + (size_t)cur.pn * tstep;
    PG8_STAGE(PG8_SB(0, 0), cB, voffB); PG8_STAGE(PG8_SA(0, 0), cA, voffA); PG8_STAGE(PG8_SB(0, 1), cB + hstep, voffB); PG8_STAGE(PG8_SA(0, 1), cA + hstep, voffA);
    if (wr == 1) PG8_BAR;
    PG8_WAIT_V(4); PG8_BAR;
    PG8_STAGE(PG8_SB(1, 0), cB + kstep, voffB); PG8_STAGE(PG8_SA(1, 0), cA + kstep, voffA); PG8_STAGE(PG8_SB(1, 1), cB + hstep + kstep, voffB);
    PG8_WAIT_V(6); PG8_BAR;
    for (;;) {
        const bool has_next = S.next(ui + 1, nxt);
        const char* nA = has_next ? (const char*)g.A + (size_t)nxt.pm * tstep : cA; const char* nB = has_next ? (const char*)g.Bt + (size_t)nxt.pn * tstep : cB;
        for (int t = 0; t < nt; t += 2) {
            const bool last = (t == nt - 2);
            const char* a1 = cA + (size_t)(t + 1) * kstep;
            const char* a2 = last ? nA : cA + (size_t)(t + 2) * kstep; const char* b2 = last ? nB : cB + (size_t)(t + 2) * kstep;
            const char* a3 = a2 + kstep; const char* b3 = b2 + kstep;
            PG8_LDB(B0, 0, 0); PG8_SCHED; PG8_LDA(At, 0, 0); PG8_STAGE(PG8_SA(1, 1), a1 + hstep, voffA);
            PG8_WAIT_L(8); PG8_BAR; PG8_WAIT_L(0); PG8_MMA(0, 0, At, B0); PG8_BAR; PG8_SCHED;
            PG8_LDB(B1, 0, 1); PG8_STAGE(PG8_SB(0, 0), b2, voffB);
            PG8_BAR; PG8_WAIT_L(0); PG8_MMA(0, 1, At, B1); PG8_BAR;
            PG8_LDA(At, 0, 1); PG8_STAGE(PG8_SA(0, 0), a2, voffA);
            PG8_BAR; PG8_WAIT_L(0); PG8_MMA(1, 0, At, B0); PG8_BAR; PG8_SCHED;
            PG8_STAGE(PG8_SB(0, 1), b2 + hstep, voffB);
            PG8_WAIT_V(6); PG8_BAR; PG8_MMA(1, 1, At, B1); PG8_BAR;
            PG8_LDB(B0, 1, 0); PG8_SCHED; PG8_LDA(At, 1, 0); PG8_STAGE(PG8_SA(0, 1), a2 + hstep, voffA);
            PG8_WAIT_L(8); PG8_BAR; PG8_WAIT_L(0); PG8_MMA(0, 0, At, B0); PG8_BAR; PG8_SCHED;
            PG8_LDB(B1, 1, 1); PG8_STAGE(PG8_SB(1, 0), b3, voffB);
            PG8_BAR; PG8_WAIT_L(0); PG8_MMA(0, 1, At, B1); PG8_BAR;
            PG8_LDA(At, 1, 1); PG8_STAGE(PG8_SA(1, 0), a3, voffA);
            PG8_BAR; PG8_WAIT_L(0); PG8_MMA(1, 0, At, B0); PG8_BAR; PG8_SCHED;
            PG8_STAGE(PG8_SB(1, 1), b3 + hstep, voffB);
            PG8_WAIT_V(6); PG8_BAR; PG8_MMA(1, 1, At, B1); PG8_BAR;
        }
        E(acc, cur, wr, wc, fr, fq);
        if (!has_next) break;
#pragma unroll
        for (int a = 0; a < 2; ++a)
#pragma unroll
            for (int b = 0; b < 2; ++b)
#pragma unroll
                for (int m = 0; m < 4; ++m)
#pragma unroll
                    for (int n = 0; n < 2; ++n) acc[a][b][m][n] = (f32x4){0.f, 0.f, 0.f, 0.f};
        cur = nxt; cA = nA; cB = nB; ++ui;
    }
    PG8_WAIT_V(0);
    if (wr == 0) PG8_BAR;
    PG8_BAR;
#undef PG8_SA
#undef PG8_SB
#undef PG8_STAGE
#undef PG8_LDA
#undef PG8_LDB
#undef PG8_MMA
#undef PG8_WAIT_V
#undef PG8_WAIT_L
#undef PG8_BAR
#undef PG8_SCHED
}

__device__ __forceinline__ u32x4 pack8(f32x4 v0, f32x4 v1) { u32x4 w; w.x = cvt_pk_bf16(v0[0], v0[1]); w.y = cvt_pk_bf16(v0[2], v0[3]); w.z = cvt_pk_bf16(v1[0], v1[1]); w.w = cvt_pk_bf16(v1[2], v1[3]); return w; }
__device__ __forceinline__ f32x4 sig4(f32x4 v) { return (f32x4){sigmoidf_(v[0]), sigmoidf_(v[1]), sigmoidf_(v[2]), sigmoidf_(v[3])}; }
__device__ __forceinline__ f32x4 silu4(f32x4 v) { return (f32x4){siluf_(v[0]), siluf_(v[1]), siluf_(v[2]), siluf_(v[3])}; }

struct EpiG1 {
    unsigned char* ws; bf16_t* gm;
    __device__ __forceinline__ void operator()(const f32x4 (&acc)[2][2][4][2], const Unit& u, int wr, int wc, int fr, int fq) const {
        const int pn = u.pn; const size_t row0 = (size_t)u.pm * BM + wr * 64 + fr; const int lc = wc * 32 + 8 * fq;
        if (pn == 14) {
            float* O = (float*)(ws + WS_KRGT);
            if (lc < 96) {
#pragma unroll
                for (int ai = 0; ai < 2; ++ai)
#pragma unroll
                    for (int m = 0; m < 4; ++m) { float* rp = O + (row0 + ai * HALF + m * 16) * 96 + lc; *(f32x4*)rp = acc[ai][0][m][0]; *(f32x4*)(rp + 4) = acc[ai][0][m][1]; }
            }
            return;
        }
        if (pn >= 19 && pn < 35) {
            bf16_t* O = (bf16_t*)(ws + WS_GMZ) + (pn - 19) * 128 + lc;
#pragma unroll
            for (int ai = 0; ai < 2; ++ai)
#pragma unroll
                for (int m = 0; m < 4; ++m) { const f32x4 a0 = sig4(acc[ai][0][m][0]) * silu4(acc[ai][1][m][0]), a1 = sig4(acc[ai][0][m][1]) * silu4(acc[ai][1][m][1]);
                    __builtin_nontemporal_store(pack8(a0, a1), (u32x4*)(O + (row0 + ai * HALF + m * 16) * 2048)); }
            return;
        }
        bf16_t* O; int ld, act = 0;
        if (pn < 4) { O = (bf16_t*)(ws + WS_KM) + pn * 256; ld = 1024; }
        else if (pn < 12) { O = (bf16_t*)(ws + WS_VM) + (pn - 4) * 256; ld = 2048; }
        else if (pn < 14) { O = (bf16_t*)(ws + WS_CKV) + (pn - 12) * 256; ld = 512; }
        else if (pn < 19) { O = (bf16_t*)(ws + WS_QM) + (pn - 15) * 256; ld = 1024; }
        else if (pn < 47) { O = (bf16_t*)(ws + WS_QA) + (pn - 35) * 256; ld = 3072; }
        else if (pn < 55) { O = (bf16_t*)(ws + WS_ZA) + (pn - 47) * 256; ld = 2048; act = 1; }
        else if (pn < 63) { O = gm + (pn - 55) * 256; ld = 2048; act = 2; }
        else { O = gm + (size_t)NT * 2048 + (pn - 63) * 256; ld = 2048; act = 2; }
        O += lc;
#pragma unroll
        for (int ai = 0; ai < 2; ++ai)
#pragma unroll
            for (int m = 0; m < 4; ++m) { bf16_t* rp = O + (row0 + ai * HALF + m * 16) * ld;
#pragma unroll
                for (int bj = 0; bj < 2; ++bj) { f32x4 v0 = acc[ai][bj][m][0], v1 = acc[ai][bj][m][1];
                    if (act == 1) { v0 = silu4(v0); v1 = silu4(v1); } else if (act == 2) { v0 = sig4(v0); v1 = sig4(v1); }
                    __builtin_nontemporal_store(pack8(v0, v1), (u32x4*)(rp + bj * HALF)); } }
    }
};
struct EpiG2 {
    unsigned char* ws;
    __device__ __forceinline__ void operator()(const f32x4 (&acc)[2][2][4][2], const Unit& u, int wr, int wc, int fr, int fq) const {
        const int pn = u.pn, pm = u.pm; const int lc = wc * 32 + 8 * fq;
        const size_t obase = pm < 64 ? (size_t)(pm >> 4) * SKV + CL + (size_t)(pm & 15) * 256 : (size_t)(pm - 64) * SKV;
        const size_t row0 = obase + wr * 64 + fr;
#pragma unroll
        for (int ai = 0; ai < 2; ++ai)
#pragma unroll
            for (int m = 0; m < 4; ++m) { const size_t r = row0 + ai * HALF + m * 16;
#pragma unroll
                for (int bj = 0; bj < 2; ++bj) {
                    bf16_t* p = pn < 8 ? (bf16_t*)(ws + WS_KB) + r * 3072 + (2 * pn + bj) * 192 + lc : (bf16_t*)(ws + WS_V2) + r * 2048 + (pn - 8) * 256 + bj * HALF + lc;
                    *(u32x4*)p = pack8(acc[ai][bj][m][0], acc[ai][bj][m][1]); } }
    }
};
__device__ __forceinline__ void unpack8(u32x4 w, f32x4& a, f32x4& b) { a = (f32x4){bflo(w.x), bfhi(w.x), bflo(w.y), bfhi(w.y)}; b = (f32x4){bflo(w.z), bfhi(w.z), bflo(w.w), bfhi(w.w)}; }
template <int ADD> struct EpiPM {
    bf16_t* U; const bf16_t* gate;
    __device__ __forceinline__ void operator()(const f32x4 (&acc)[2][2][4][2], const Unit& u, int wr, int wc, int fr, int fq) const {
        const size_t row0 = (size_t)u.pm * BM + wr * 64 + fr; const int col0 = u.pn * BM + wc * 32 + 8 * fq;
#pragma unroll
        for (int ai = 0; ai < 2; ++ai) {
            u32x4 gw[4][2], uw[4][2];
#pragma unroll
            for (int m = 0; m < 4; ++m)
#pragma unroll
                for (int bj = 0; bj < 2; ++bj) { const size_t off = (row0 + ai * HALF + m * 16) * 2048 + col0 + bj * HALF;
                    gw[m][bj] = *(const u32x4*)(gate + off); if (ADD) uw[m][bj] = *(const u32x4*)(U + off); }
#pragma unroll
            for (int m = 0; m < 4; ++m)
#pragma unroll
                for (int bj = 0; bj < 2; ++bj) { const size_t off = (row0 + ai * HALF + m * 16) * 2048 + col0 + bj * HALF;
                    f32x4 g0, g1; unpack8(gw[m][bj], g0, g1);
                    f32x4 v0 = g0 * acc[ai][bj][m][0], v1 = g1 * acc[ai][bj][m][1];
                    if (ADD) { f32x4 p0, p1; unpack8(uw[m][bj], p0, p1); v0 += p0; v1 += p1; }
                    *(u32x4*)(U + off) = pack8(v0, v1); }
        }
    }
};
struct EpiOut {
    const float* x; float* out; const float* gate;
    __device__ __forceinline__ void operator()(const f32x4 (&acc)[2][2][4][2], const Unit& u, int wr, int wc, int fr, int fq) const {
        const size_t row0 = (size_t)u.pm * BM + wr * 64 + fr; const int col0 = u.pn * BM + wc * 32 + 8 * fq; const float* gp = gate + (size_t)(u.pm >> 4) * 6144 + col0;
        f32x4 gv[2][2];
#pragma unroll
        for (int bj = 0; bj < 2; ++bj) { gv[bj][0] = *(const f32x4*)(gp + bj * HALF); gv[bj][1] = *(const f32x4*)(gp + bj * HALF + 4); }
#pragma unroll
        for (int ai = 0; ai < 2; ++ai) {
            f32x4 xv[4][2][2];
#pragma unroll
            for (int m = 0; m < 4; ++m)
#pragma unroll
                for (int bj = 0; bj < 2; ++bj) { const size_t off = (row0 + ai * HALF + m * 16) * 2048 + col0 + bj * HALF; xv[m][bj][0] = *(const f32x4*)(x + off); xv[m][bj][1] = *(const f32x4*)(x + off + 4); }
#pragma unroll
            for (int m = 0; m < 4; ++m)
#pragma unroll
                for (int bj = 0; bj < 2; ++bj) { const size_t off = (row0 + ai * HALF + m * 16) * 2048 + col0 + bj * HALF;
                    *(f32x4*)(out + off) = xv[m][bj][0] + gv[bj][0] * acc[ai][bj][m][0]; *(f32x4*)(out + off + 4) = xv[m][bj][1] + gv[bj][1] * acc[ai][bj][m][1]; }
        }
    }
};
}
__device__ __forceinline__ int win_src(int nq) {
    const int pn = nq >> 3, r = (nq & 7) * 32;
    if (pn < 4) return pn * 256 + r;
    if (pn < 12) return 1024 + (pn - 4) * 256 + r;
    if (pn < 14) return 3104 + (pn - 12) * 256 + r;
    if (pn == 14) return r < 64 ? 3616 + r : (r == 64 ? 3072 : -1);
    if (pn < 19) return 3680 + (pn - 15) * 256 + r;
    if (pn < 35) { const int j0 = (pn - 19) * 128; return r < 128 ? 4704 + j0 + r : 6752 + j0 + (r - 128); }
    if (pn < 47) return 8800 + (pn - 35) * 256 + r;
    if (pn < 55) return 11872 + (pn - 47) * 256 + r;
    return 13920 + (pn - 55) * 256 + r;
}
__device__ __forceinline__ void tr_addr(const Params& p, int t, const float*& q  , bf16_t*& dstp  ) {
    constexpr int T_WIN = 284 * 32, T_UKV = 64 * 8;
    const int tid = threadIdx.x, kk = tid >> 3, jg = (tid & 7) * 8, hi32 = jg >> 5, n = tid >> 3, kg = (tid & 7) * 8;
    if (t < T_WIN) { const int nt = t % 284, kt = t / 284; const int c = win_src(nt * 2 + hi32);
        q = c >= 0 ? p.w_in + (size_t)(kt * 64 + kk) * IN_COLS + c + (jg & 31) : nullptr;
        dstp = (bf16_t*)(p.ws + WS_WIN) + (size_t)(nt * 64 + n) * LDH + kt * 64 + kg; }
    else if (t < T_WIN + T_UKV) { const int u = t - T_WIN, nt = u >> 3, kt = u & 7;
        q = (nt < 32 ? p.w_uk + nt * 64 : p.w_uv + (nt - 32) * 64) + (size_t)(kt * 64 + kk) * 2048 + jg;
        dstp = (bf16_t*)(p.ws + WS_WUKV) + (size_t)(nt * 64 + n) * 512 + kt * 64 + kg; }
    else { const int u = t - T_WIN - T_UKV, which = u >> 10, nt = (u >> 5) & 31, kt = u & 31;
        q = (which == 0 ? p.w_proj_m : which == 1 ? p.w_proj_a : p.w_out) + (size_t)(kt * 64 + kk) * 2048 + nt * 64 + jg;
        dstp = (bf16_t*)(p.ws + (which == 0 ? WS_WPM : which == 1 ? WS_WPA : WS_WOUT)) + (size_t)(nt * 64 + n) * 2048 + kt * 64 + kg; }
}
__device__ __forceinline__ void tr_load(const float* q, f32x4& a, f32x4& b) {
    a = (f32x4){0.f, 0.f, 0.f, 0.f}; b = a;
    if (q) { a = *(const f32x4*)q; b = *(const f32x4*)(q + 4); }
}
__device__ __forceinline__ void tr_store(float* tile  , bf16_t* dstp, const f32x4 a, const f32x4 b) {
    const int tid = threadIdx.x;
    { const int kk = tid >> 3, jg = (tid & 7) * 8; float* t = tile + kk * 65 + jg; t[0] = a[0]; t[1] = a[1]; t[2] = a[2]; t[3] = a[3]; t[4] = b[0]; t[5] = b[1]; t[6] = b[2]; t[7] = b[3]; }
    __syncthreads();
    { const int n = tid >> 3, kg = (tid & 7) * 8; const float* t = tile + kg * 65 + n;
      u32x4 w; w.x = cvt_pk_bf16(t[0], t[65]); w.y = cvt_pk_bf16(t[130], t[195]); w.z = cvt_pk_bf16(t[260], t[325]); w.w = cvt_pk_bf16(t[390], t[455]);
      *(u32x4*)dstp = w; }
}
__device__ void phase_prep(const Params& p, unsigned char* smem) {
    const int tid = threadIdx.x, G = gridDim.x, bid = blockIdx.x;
    float* sm = (float*)smem;
    if (bid < 256) {
        float* sv = sm;
        float* red = sm + 5 * 2048;
        for (int i = tid; i < 5 * 2048; i += NTHR) { const int v = i >> 11, k = i & 2047; const float cv = v < 4 ? p.c[v * 2048 + k] : p.c_ctx[k]; sv[i] = siluf_(cv); }
        __syncthreads();
        for (int cgp = bid; cgp < 256; cgp += G) {
            const int col = tid % 24, kg = tid / 24;
            if (kg < 21) { float a0 = 0, a1 = 0, a2 = 0, a3 = 0, a4 = 0; const float* w = p.ada_w + cgp * 24 + col;
                for (int k0 = kg; k0 < 2048; k0 += 21 * 14) {
                    float wv[14];
#pragma unroll
                    for (int u = 0; u < 14; ++u) { const int k = k0 + 21 * u; wv[u] = k < 2048 ? w[(size_t)k * 6144] : 0.f; }
#pragma unroll
                    for (int u = 0; u < 14; ++u) { const int k = k0 + 21 * u; if (k < 2048) { a0 += sv[k] * wv[u]; a1 += sv[2048 + k] * wv[u]; a2 += sv[4096 + k] * wv[u]; a3 += sv[6144 + k] * wv[u]; a4 += sv[8192 + k] * wv[u]; } }
                }
                float* r = red + (kg * 24 + col) * 5; r[0] = a0; r[1] = a1; r[2] = a2; r[3] = a3; r[4] = a4; }
            __syncthreads();
            if (tid < 120) { const int c2 = tid / 5, v = tid % 5; float s = 0; for (int g = 0; g < 21; ++g) s += red[(g * 24 + c2) * 5 + v];
                ((float*)(p.ws + WS_MOD))[v * 6144 + cgp * 24 + c2] = s + p.ada_b[cgp * 24 + c2]; }
            __syncthreads();
        }
    }
    float* tile = sm;
    constexpr int T_ALL = 284 * 32 + 64 * 8 + 3 * 32 * 32;
    const int n = bid < T_ALL ? (T_ALL - bid + G - 1) / G : 0;
    f32x4 A4[4], B4[4]; bf16_t* D4[4];
#pragma unroll
    for (int u = 0; u < 4; ++u) { A4[u] = (f32x4){0.f, 0.f, 0.f, 0.f}; B4[u] = A4[u]; D4[u] = nullptr; if (u < n) { const float* q; tr_addr(p, bid + u * G, q, D4[u]); tr_load(q, A4[u], B4[u]); } }
    for (int k0 = 0; k0 < n; k0 += 4) {
#pragma unroll
        for (int u = 0; u < 4; ++u) { const int k = k0 + u;
            if (k < n) { tr_store(tile + (u & 1) * (64 * 65), D4[u], A4[u], B4[u]);
                if (k + 4 < n) { const float* q; tr_addr(p, bid + (k + 4) * G, q, D4[u]); tr_load(q, A4[u], B4[u]); } } }
    }
}
__device__ void phase_hrows(const Params& p, unsigned char* smem) {
    const int tid = threadIdx.x, G = gridDim.x, lane = tid & 63, wid = tid >> 6;
    float* red = (float*)smem;
    const float* MOD = (const float*)(p.ws + WS_MOD);
    const f32x4 g = *(const f32x4*)(p.norm_g + tid * 4);
    int it = 0, vcur = -1; f32x4 sh = (f32x4){0.f, 0.f, 0.f, 0.f}, sc = sh;
    auto rowptr = [&](int r) { return (r < NT ? p.x + (size_t)r * 2048 : p.ctx + (size_t)(r - NT) * 2048) + tid * 4; };
    f32x4 xq[4];
#pragma unroll
    for (int u = 0; u < 4; ++u) { const int r = blockIdx.x + u * G; xq[u] = (f32x4){0.f, 0.f, 0.f, 0.f}; if (r < NR) xq[u] = *(const f32x4*)rowptr(r); }
    for (int row0 = blockIdx.x; row0 < NR; row0 += 4 * G)
#pragma unroll
    for (int u = 0; u < 4; ++u) { const int row = row0 + u * G; if (row < NR) { ++it;
        const int v = row < NT ? row >> 12 : 4;
        const f32x4 xv = xq[u];
        { const int rn = row + 4 * G; if (rn < NR) xq[u] = *(const f32x4*)rowptr(rn); }
        float ss = xv[0] * xv[0] + xv[1] * xv[1] + xv[2] * xv[2] + xv[3] * xv[3];
        ss = wave_sum(ss);
        float* r = red + (it & 1) * 8;
        if (lane == 0) r[wid] = ss;
        __syncthreads();
        float tot = 0;
#pragma unroll
        for (int i = 0; i < 8; ++i) tot += r[i];
        const float rstd = rsqrtf(tot * (1.0f / 2048.0f) + EPS);
        if (v != vcur) { sh = *(const f32x4*)(MOD + v * 6144 + tid * 4); sc = *(const f32x4*)(MOD + v * 6144 + 2048 + tid * 4); vcur = v; }
        const f32x4 y = xv * rstd * g * (sc + 1.0f) + sh;
        u32x2 w; w.x = cvt_pk_bf16(y[0], y[1]); w.y = cvt_pk_bf16(y[2], y[3]);
        *(u32x2*)((bf16_t*)(p.ws + WS_H) + (size_t)row * LDH + tid * 4) = w;
    } }
    __syncthreads();
}
namespace ml {
constexpr int QS = 136, KTS = 72, CTS = 136;
constexpr int OFF_Q = 0, OFF_K = 17408, OFF_KT = 34816, OFF_VT = 53248, OFF_VWT = 62464, OFF_P = 71680, OFF_CT = 80896, OFF_F = 98304;
constexpr int F_N = 0, F_ROWC = 128, F_AV = 192, F_SINT = 256, F_EINV = 320, F_WS = 384, F_PSUM = 448, F_QN = 576, F_CWQ = 640, F_CWK = 1280, F_CBQ = 1920, F_CBK = 2048;
__device__ __forceinline__ int crow(int r, int hi) { return (r & 3) + 8 * (r >> 2) + 4 * hi; }
__device__ __forceinline__ bf16x8 ldfrag(const unsigned char* base, int row, int stride, int k) { return *(const bf16x8*)(base + ((size_t)row * stride + k) * 2); }


template <int CTRL, int ROWMASK> __device__ __forceinline__ float dpp_f(float oldv, float src) {
    return __int_as_float(__builtin_amdgcn_update_dpp(__float_as_int(oldv), __float_as_int(src), CTRL, ROWMASK, 0xf, false)); }
__device__ __forceinline__ float scan_add64(float x) {
    x += dpp_f<0x111, 0xf>(0.f, x); x += dpp_f<0x112, 0xf>(0.f, x); x += dpp_f<0x114, 0xf>(0.f, x); x += dpp_f<0x118, 0xf>(0.f, x);
    x += dpp_f<0x142, 0xa>(0.f, x); x += dpp_f<0x143, 0xc>(0.f, x); return x; }
__device__ __forceinline__ float scan_max64(float x) {
    constexpr float NEG = -3.0e38f;
    x = fmaxf(x, dpp_f<0x111, 0xf>(NEG, x)); x = fmaxf(x, dpp_f<0x112, 0xf>(NEG, x)); x = fmaxf(x, dpp_f<0x114, 0xf>(NEG, x)); x = fmaxf(x, dpp_f<0x118, 0xf>(NEG, x));
    x = fmaxf(x, dpp_f<0x142, 0xa>(NEG, x)); x = fmaxf(x, dpp_f<0x143, 0xc>(NEG, x)); return x; }

__device__ void phase_conv(const Params& p) {
    const int tid = threadIdx.x, G = gridDim.x;
    constexpr int NKI = (NR / 64) * 8, NQI = (NT / 64) * 8, NI = NKI + NQI;
    const int i = tid >> 3;
    auto load_item = [&](int item, u32x4 (&W)[10]) {
        const bool isq = item >= NKI; const int it = isq ? item - NKI : item; const int h = it & 7, row0 = (it >> 3) * 64;
        const int seq0 = row0 < NT ? (row0 & ~(SEQ - 1)) : NT + ((row0 - NT) & ~(CL - 1)), seqlen = row0 < NT ? SEQ : CL;
        const bf16_t* src = (const bf16_t*)(p.ws + (isq ? WS_QM : WS_KM)); const int t = row0 + i - seq0;
#pragma unroll
        for (int half = 0; half < 2; ++half) { const int d0 = ((tid & 7) + half * 8) * 8;
#pragma unroll
            for (int j = 0; j < 5; ++j) { const int tt = t + j - 2; W[half * 5 + j] = (u32x4){0u, 0u, 0u, 0u};
                if (tt >= 0 && tt < seqlen) W[half * 5 + j] = *(const u32x4*)(src + (size_t)(seq0 + tt) * 1024 + h * 128 + d0); } }
    };
    auto compute_item = [&](int item, const u32x4 (&W)[10]) {
        const bool isq = item >= NKI; const int it = isq ? item - NKI : item; const int h = it & 7, row0 = (it >> 3) * 64;
        bf16_t* dst = (bf16_t*)(p.ws + (isq ? WS_QC : WS_KC));
        const float* cw = p.conv_w + (isq ? 0 : 1024) + h * 128; const float* cb = p.conv_b + (isq ? 0 : 1024) + h * 128;
        const float sc = isq ? 0.08838834764831845f : 1.0f;
        f32x4 cwv[2][6][2];
#pragma unroll
        for (int half = 0; half < 2; ++half) { const int d0 = ((tid & 7) + half * 8) * 8;
#pragma unroll
            for (int j = 0; j < 5; ++j) { cwv[half][j][0] = *(const f32x4*)(cw + j * 2048 + d0); cwv[half][j][1] = *(const f32x4*)(cw + j * 2048 + d0 + 4); }
            cwv[half][5][0] = *(const f32x4*)(cb + d0); cwv[half][5][1] = *(const f32x4*)(cb + d0 + 4); }
#pragma unroll
        for (int half = 0; half < 2; ++half) { const int d0 = ((tid & 7) + half * 8) * 8;
            f32x4 a0 = cwv[half][5][0], a1 = cwv[half][5][1];
#pragma unroll
            for (int j = 0; j < 5; ++j) { const u32x4 w = W[half * 5 + j];
                const f32x4 c0 = cwv[half][j][0], c1 = cwv[half][j][1];
                a0 += c0 * (f32x4){bflo(w.x), bfhi(w.x), bflo(w.y), bfhi(w.y)}; a1 += c1 * (f32x4){bflo(w.z), bfhi(w.z), bflo(w.w), bfhi(w.w)}; }
#pragma unroll
            for (int e = 0; e < 4; ++e) { a0[e] = a0[e] * __builtin_amdgcn_rcpf(1.0f + __expf(-a0[e])) * sc; a1[e] = a1[e] * __builtin_amdgcn_rcpf(1.0f + __expf(-a1[e])) * sc; }
            u32x4 o; o.x = cvt_pk_bf16(a0[0], a0[1]); o.y = cvt_pk_bf16(a0[2], a0[3]); o.z = cvt_pk_bf16(a1[0], a1[1]); o.w = cvt_pk_bf16(a1[2], a1[3]);
            *(u32x4*)(dst + (size_t)(row0 + i) * 1024 + h * 128 + d0) = o; }
    };
    u32x4 Wa[10], Wb[10];
    int item = blockIdx.x;
    if (item < NI) load_item(item, Wa);
    for (; item < NI; item += 2 * G) {
        if (item + G < NI) load_item(item + G, Wb);
        compute_item(item, Wa);
        if (item + G < NI) { if (item + 2 * G < NI) load_item(item + 2 * G, Wa); compute_item(item + G, Wb); }
    }
}

__device__ void phase_mlstm(const Params& p, unsigned char* smem) {
    const int tid = threadIdx.x, G = gridDim.x, lane = tid & 63, wid = __builtin_amdgcn_readfirstlane(tid >> 6), r32 = lane & 31, hi = lane >> 5;
    float* F = (float*)(smem + OFF_F);
    const bf16_t* KC = (const bf16_t*)(p.ws + WS_KC); const bf16_t* VM = (const bf16_t*)(p.ws + WS_VM); const bf16_t* QC = (const bf16_t*)(p.ws + WS_QC);
    const float* KRGT = (const float*)(p.ws + WS_KRGT);
    for (int it0 = blockIdx.x; it0 < 256; it0 += G) {
        const int item = (G == 256) ? (((it0 & 7) + 8 * (it0 >> 6)) << 3) + ((it0 >> 3) & 7) : it0;
        const int sl = item & 3, dir = (item >> 2) & 1, h = (item >> 3) & 7, b = item >> 6;
        bf16_t* HX = (bf16_t*)(p.ws + (dir ? WS_HB : WS_HF));
        if (tid < 128) F[F_N + tid] = 0.f;
        for (int i = tid; i < 64 * CTS / 2; i += NTHR) ((unsigned*)(smem + OFF_CT))[i] = 0u;
        f32x16 Cst; for (int r = 0; r < 16; ++r) Cst[r] = 0.f;
        float m_prev = -1e30f;
        const float gbi = p.gate_b[(2 * dir) * 8 + h], gbf = p.gate_b[(2 * dir + 1) * 8 + h];
        __syncthreads();
        u32x4 pk0, pk1, pq0, pq1, pv; float pgi, pgf;
#define ML_CHUNK(stx, isctx_, tokbase_, rowbase_) const bool isctx_ = (stx) < 4; const int tokbase_ = (isctx_ ? (dir ? 3 - (stx) : (stx)) : (dir ? 67 - (stx) : (stx) - 4)) * 64, rowbase_ = isctx_ ? NT + b * CL : b * SEQ
#define ML_LBAR() do { asm volatile("s_waitcnt lgkmcnt(0)" ::: "memory"); __builtin_amdgcn_s_barrier(); asm volatile("" ::: "memory"); } while (0)
#define ML_LOAD(stx) do { ML_CHUNK(stx, ic_, tb_, rb_); \
            { const int i0 = tid & 31, c0 = (tid >> 5) * 8; const size_t r0 = (size_t)(rb_ + tb_ + (dir ? 63 - i0 : i0)) * 1024 + h * 128 + c0, r1 = (size_t)(rb_ + tb_ + (dir ? 31 - i0 : 32 + i0)) * 1024 + h * 128 + c0; \
              pk0 = *(const u32x4*)(KC + r0); pk1 = *(const u32x4*)(KC + r1); if (!ic_) { pq0 = *(const u32x4*)(QC + r0); pq1 = *(const u32x4*)(QC + r1); } } \
            { const int iv = tid & 63; pv = *(const u32x4*)(VM + (size_t)(rb_ + tb_ + (dir ? 63 - iv : iv)) * 2048 + h * 256 + sl * 64 + (tid >> 6) * 8); } \
            { const float* gp = KRGT + (size_t)(rb_ + tb_ + (dir ? 63 - lane : lane)) * 96 + 64 + h; pgi = gp[(2 * dir) * 8]; pgf = gp[(2 * dir + 1) * 8]; } } while (0)
#define ML_SCAN(bi) do { float* FB_ = F + 640 + (bi) * 384; \
            const float gi = pgi + gbi, gf = pgf + gbf; \
            const float lf = fminf(gf, 0.f) - __logf(1.0f + __expf(-fabsf(gf))); \
            const float bc = scan_add64(lf); \
            const float a_ = gi - bc; const float pm = scan_max64(a_); \
            const float btot = __int_as_float(__builtin_amdgcn_readlane(__float_as_int(bc), 63)); \
            const float mrow = bc + fmaxf(m_prev, pm); \
            const float wsraw = btot + a_; const float wmax = btot + __int_as_float(__builtin_amdgcn_readlane(__float_as_int(pm), 63)); \
            const float m_new = fmaxf(btot + m_prev, wmax); \
            FB_[lane] = bc - mrow; FB_[64 + lane] = a_; FB_[128 + lane] = __expf(bc + m_prev - mrow); FB_[192 + lane] = __expf(-mrow); { const float wsv_ = __expf(wsraw - m_new); FB_[256 + lane] = wsv_; ((bf16_t*)(FB_ + 324))[lane] = (bf16_t)(cvt_pk_bf16(wsv_, 0.f) & 0xffff); } \
            if (lane == 0) FB_[320] = __expf(btot + m_prev - m_new); \
            m_prev = m_new; } while (0)
        ML_LOAD(0);
        if (wid == 3) ML_SCAN(0);
        __syncthreads();
        for (int st = 0; st < 68; ++st) {
            ML_CHUNK(st, isctx, tokbase, rowbase);
            const float* FBc = F + 640 + (st & 1) * 384; const float decay = FBc[320];
            {
                const int i0 = tid & 31, c0 = (tid >> 5) * 8;
                *(u32x4*)(smem + OFF_K + (i0 * QS + c0) * 2) = pk0; *(u32x4*)(smem + OFF_K + ((32 + i0) * QS + c0) * 2) = pk1;
                bf16_t* kt = (bf16_t*)(smem + OFF_KT) + c0 * KTS + i0;
                kt[0] = (bf16_t)(pk0.x & 0xffff); kt[KTS] = (bf16_t)(pk0.x >> 16); kt[2 * KTS] = (bf16_t)(pk0.y & 0xffff); kt[3 * KTS] = (bf16_t)(pk0.y >> 16);
                kt[4 * KTS] = (bf16_t)(pk0.z & 0xffff); kt[5 * KTS] = (bf16_t)(pk0.z >> 16); kt[6 * KTS] = (bf16_t)(pk0.w & 0xffff); kt[7 * KTS] = (bf16_t)(pk0.w >> 16);
                kt += 32;
                kt[0] = (bf16_t)(pk1.x & 0xffff); kt[KTS] = (bf16_t)(pk1.x >> 16); kt[2 * KTS] = (bf16_t)(pk1.y & 0xffff); kt[3 * KTS] = (bf16_t)(pk1.y >> 16);
                kt[4 * KTS] = (bf16_t)(pk1.z & 0xffff); kt[5 * KTS] = (bf16_t)(pk1.z >> 16); kt[6 * KTS] = (bf16_t)(pk1.w & 0xffff); kt[7 * KTS] = (bf16_t)(pk1.w >> 16);
                if (!isctx) { *(u32x4*)(smem + OFF_Q + (i0 * QS + c0) * 2) = pq0; *(u32x4*)(smem + OFF_Q + ((32 + i0) * QS + c0) * 2) = pq1; }
                const int i = tid & 63, cg8 = (tid >> 6) * 8; const float wsi = FBc[256 + i];
                const float vv[8] = {bflo(pv.x), bfhi(pv.x), bflo(pv.y), bfhi(pv.y), bflo(pv.z), bfhi(pv.z), bflo(pv.w), bfhi(pv.w)};
                bf16_t* vt = (bf16_t*)(smem + OFF_VT) + cg8 * KTS + i; bf16_t* vwt = (bf16_t*)(smem + OFF_VWT) + cg8 * KTS + i;
                vt[0] = (bf16_t)(pv.x & 0xffff); vt[KTS] = (bf16_t)(pv.x >> 16); vt[2 * KTS] = (bf16_t)(pv.y & 0xffff); vt[3 * KTS] = (bf16_t)(pv.y >> 16);
                vt[4 * KTS] = (bf16_t)(pv.z & 0xffff); vt[5 * KTS] = (bf16_t)(pv.z >> 16); vt[6 * KTS] = (bf16_t)(pv.w & 0xffff); vt[7 * KTS] = (bf16_t)(pv.w >> 16);
#pragma unroll
                for (int e = 0; e < 8; e += 2) { const unsigned pw = cvt_pk_bf16(vv[e] * wsi, vv[e + 1] * wsi); vwt[e * KTS] = (bf16_t)(pw & 0xffff); vwt[(e + 1) * KTS] = (bf16_t)(pw >> 16); }
            }
            if (st + 1 < 68) ML_LOAD(st + 1);
            ML_LBAR();
            f32x16 accQC; for (int r = 0; r < 16; ++r) accQC[r] = 0.f;
            if (!isctx) {
                { const int i = tid >> 3, part = tid & 7; const u32x4 q0 = *(const u32x4*)(smem + OFF_Q + (i * QS + part * 16) * 2), q1 = *(const u32x4*)(smem + OFF_Q + (i * QS + part * 16 + 8) * 2);
                  const float* nn = F + F_N + part * 16;
                  float s = bflo(q0.x) * nn[0] + bfhi(q0.x) * nn[1] + bflo(q0.y) * nn[2] + bfhi(q0.y) * nn[3] + bflo(q0.z) * nn[4] + bfhi(q0.z) * nn[5] + bflo(q0.w) * nn[6] + bfhi(q0.w) * nn[7]
                          + bflo(q1.x) * nn[8] + bfhi(q1.x) * nn[9] + bflo(q1.y) * nn[10] + bfhi(q1.y) * nn[11] + bflo(q1.z) * nn[12] + bfhi(q1.z) * nn[13] + bflo(q1.w) * nn[14] + bfhi(q1.w) * nn[15];
                  s += dpp_f<0x111, 0xf>(0.f, s); s += dpp_f<0x112, 0xf>(0.f, s); s += dpp_f<0x114, 0xf>(0.f, s);
                  if (part == 7) F[F_QN + i] = s; }
                if (wid < 4) {
                    const int stile = wid & 1, ttile = wid >> 1; const int t = 32 * ttile + r32;
                    f32x16 acc; for (int r = 0; r < 16; ++r) acc[r] = 0.f;
                    float vals[16]; float psum = 0.f;
                    if (!(stile == 1 && ttile == 0)) {
#pragma unroll 2
                        for (int kk = 0; kk < 8; ++kk) acc = __builtin_amdgcn_mfma_f32_32x32x16_bf16(ldfrag(smem + OFF_K, 32 * stile + r32, QS, kk * 16 + hi * 8), ldfrag(smem + OFF_Q, t, QS, kk * 16 + hi * 8), acc, 0, 0, 0);
                        const float rc = FBc[t];
#pragma unroll
                        for (int r = 0; r < 16; ++r) { const int s = 32 * stile + crow(r, hi); const float e = __expf(fminf(rc + FBc[64 + s], 0.f)); vals[r] = s <= t ? acc[r] * e : 0.f; psum += vals[r]; }
                    } else {
#pragma unroll
                        for (int r = 0; r < 16; ++r) vals[r] = 0.f;
                    }
                    { auto rr = __builtin_amdgcn_permlane32_swap(__float_as_uint(psum), __float_as_uint(psum), false, false); psum = __uint_as_float(rr[0]) + __uint_as_float(rr[1]); }
                    if (hi == 0) F[F_PSUM + stile * 64 + t] = psum;
#pragma unroll
                    for (int g4 = 0; g4 < 4; ++g4) { u32x2 w; w.x = cvt_pk_bf16(vals[4 * g4], vals[4 * g4 + 1]); w.y = cvt_pk_bf16(vals[4 * g4 + 2], vals[4 * g4 + 3]);
                        *(u32x2*)(smem + OFF_P + (t * KTS + 32 * stile + 8 * g4 + 4 * hi) * 2) = w; }
                } else {
                    const int w4 = wid - 4, ttile = w4 & 1, ctile = w4 >> 1;
#pragma unroll 2
                    for (int kk = 0; kk < 8; ++kk) accQC = __builtin_amdgcn_mfma_f32_32x32x16_bf16(ldfrag(smem + OFF_Q, 32 * ttile + r32, QS, kk * 16 + hi * 8), ldfrag(smem + OFF_CT, 32 * ctile + r32, CTS, kk * 16 + hi * 8), accQC, 0, 0, 0);
                }
            }
            ML_LBAR();
            if (!isctx && wid >= 4) {
                const int w4 = wid - 4, ttile = w4 & 1, ctile = w4 >> 1;
                f32x16 accPV; for (int r = 0; r < 16; ++r) accPV[r] = 0.f;
#pragma unroll
                for (int kk = 0; kk < 4; ++kk) accPV = __builtin_amdgcn_mfma_f32_32x32x16_bf16(ldfrag(smem + OFF_P, 32 * ttile + r32, KTS, kk * 16 + hi * 8), ldfrag(smem + OFF_VT, 32 * ctile + r32, KTS, kk * 16 + hi * 8), accPV, 0, 0, 0);
                const int c = 32 * ctile + r32;
                float inv[16], sig[16];
#pragma unroll
                for (int r = 0; r < 16; ++r) { const int t = 32 * ttile + crow(r, hi); const float si = FBc[128 + t];
                    const float den = F[F_PSUM + t] + F[F_PSUM + 64 + t] + si * F[F_QN + t];
                    inv[r] = __builtin_amdgcn_rcpf(fmaxf(fabsf(den), FBc[192 + t])); sig[r] = si; }
#pragma unroll
                for (int r = 0; r < 16; ++r) { const int t = 32 * ttile + crow(r, hi); const float hv = (accPV[r] + sig[r] * accQC[r]) * inv[r];
                    const int tok = tokbase + (dir ? 63 - t : t);
                    HX[(size_t)(b * SEQ + tok) * 2048 + h * 256 + sl * 64 + c] = (bf16_t)(cvt_pk_bf16(hv, 0.f) & 0xffff); }
            }
            {
                const int dtile = wid & 3, ctile = wid >> 2;
#pragma unroll
                for (int r = 0; r < 16; ++r) Cst[r] *= decay;
#pragma unroll
                for (int kk = 0; kk < 4; ++kk) Cst = __builtin_amdgcn_mfma_f32_32x32x16_bf16(ldfrag(smem + OFF_KT, 32 * dtile + r32, KTS, kk * 16 + hi * 8), ldfrag(smem + OFF_VWT, 32 * ctile + r32, KTS, kk * 16 + hi * 8), Cst, 0, 0, 0);
#pragma unroll
                for (int g4 = 0; g4 < 4; ++g4) { u32x2 w; w.x = cvt_pk_bf16(Cst[4 * g4], Cst[4 * g4 + 1]); w.y = cvt_pk_bf16(Cst[4 * g4 + 2], Cst[4 * g4 + 3]);
                    *(u32x2*)(smem + OFF_CT + ((32 * ctile + r32) * CTS + 32 * dtile + 8 * g4 + 4 * hi) * 2) = w; }
            }
            if (wid < 4) {
                f32x16 accN; for (int r = 0; r < 16; ++r) accN[r] = 0.f;
                const bf16_t* wsb = (const bf16_t*)(FBc + 324);
#pragma unroll
                for (int kk = 0; kk < 4; ++kk) { bf16x8 af = *(const bf16x8*)(wsb + kk * 16 + hi * 8); if (r32 != 0) af = (bf16x8){0, 0, 0, 0, 0, 0, 0, 0};
                    accN = __builtin_amdgcn_mfma_f32_32x32x16_bf16(af, ldfrag(smem + OFF_KT, 32 * wid + r32, KTS, kk * 16 + hi * 8), accN, 0, 0, 0); }
                if (hi == 0) F[F_N + 32 * wid + r32] = decay * F[F_N + 32 * wid + r32] + accN[0];
            }
            if (wid == 3 && st + 1 < 68) ML_SCAN((st + 1) & 1);
            ML_LBAR();
        }
    }
}
}
__device__ __forceinline__ void rope_pair(float& val, int i  , int tpos) {
    const int ax = i >> 5, half = (i >> 4) & 1, f = i & 15;
    const float partner = __shfl_xor(val, 16);
    const float pos = (float)(ax == 0 ? (tpos >> 6) : (tpos & 63));
    const float freq = exp2f(-(float)f * (13.287712379549449f / 16.0f));
    const float ang = pos * freq, rev = ang * 0.15915494309189535f;
    const float sn = __builtin_amdgcn_sinf(rev), cs = __builtin_amdgcn_cosf(rev);
    const float x1 = half ? partner : val, x2 = half ? val : partner;
    val = half ? (x1 * sn + x2 * cs) : (x1 * cs - x2 * sn);
}

__device__ __forceinline__ void rope8(float (&v)[8], int sub, int tpos, bool apply) {
    const int ax = (sub >> 2) & 1, half = (sub >> 1) & 1; const float pos = (float)(ax == 0 ? (tpos >> 6) : (tpos & 63));
#pragma unroll
    for (int e = 0; e < 8; ++e) {
        const float partner = __shfl_xor(v[e], 2);
        const float freq = exp2f(-(float)((sub & 1) * 8 + e) * (13.287712379549449f / 16.0f));
        const float rev = pos * freq * 0.15915494309189535f;
        const float sn = __builtin_amdgcn_sinf(rev), cs = __builtin_amdgcn_cosf(rev);
        const float x1 = half ? partner : v[e], x2 = half ? v[e] : partner;
        const float r = half ? (x1 * sn + x2 * cs) : (x1 * cs - x2 * sn);
        if (apply && sub >= 16) v[e] = r;
    }
}
__device__ __forceinline__ float half_sum(float v) { for (int o = 16; o >= 1; o >>= 1) v += __shfl_xor(v, o); return v; }
__device__ void phase_elem(const Params& p) {
    const int tid = threadIdx.x, G = gridDim.x, lane = tid & 63, wid = tid >> 6;
    {
        const bf16_t* HF = (const bf16_t*)(p.ws + WS_HF); const bf16_t* HB = (const bf16_t*)(p.ws + WS_HB); bf16_t* GZ = (bf16_t*)(p.ws + WS_GMZ);
        const f32x4 g = *(const f32x4*)(p.mh_norm_g + tid * 4);
        for (int row0 = blockIdx.x; row0 < NT; row0 += 4 * G) {
            u32x2 av[4], bv[4], zv[4];
#pragma unroll
            for (int u = 0; u < 4; ++u) { const int row = row0 + u * G; if (row < NT) { const size_t off = (size_t)row * 2048 + tid * 4; av[u] = *(const u32x2*)(HF + off); bv[u] = *(const u32x2*)(HB + off); zv[u] = *(const u32x2*)(GZ + off); } }
#pragma unroll
            for (int u = 0; u < 4; ++u) { const int row = row0 + u * G; if (row < NT) { const size_t off = (size_t)row * 2048 + tid * 4; const u32x2 a = av[u], b = bv[u], z = zv[u];
                const f32x4 s = (f32x4){bflo(a.x) + bflo(b.x), bfhi(a.x) + bfhi(b.x), bflo(a.y) + bflo(b.y), bfhi(a.y) + bfhi(b.y)};
                const float ss = wave_sum(s[0] * s[0] + s[1] * s[1] + s[2] * s[2] + s[3] * s[3]);
                const float rstd = rsqrtf(ss * (1.0f / 256.0f) + EPS);
                const f32x4 y = s * rstd * g * (f32x4){bflo(z.x), bfhi(z.x), bflo(z.y), bfhi(z.y)};
                u32x2 w; w.x = cvt_pk_bf16(y[0], y[1]); w.y = cvt_pk_bf16(y[2], y[3]);
                *(u32x2*)(GZ + off) = w; } }
        }
    }
    {
        bf16_t* QA = (bf16_t*)(p.ws + WS_QA); const int sub = lane & 31, subc = sub < 24 ? sub : 23;
        const f32x4 ga = *(const f32x4*)(p.q_norm_g + subc * 8), gb = *(const f32x4*)(p.q_norm_g + subc * 8 + 4);
        for (int it0 = (blockIdx.x * 8 + wid) * 2 + (lane >> 5); it0 < NT * 16; it0 += 4 * G * 16) {
            u32x4 wv[4];
#pragma unroll
            for (int u = 0; u < 4; ++u) { const int it = it0 + u * G * 16; if (it < NT * 16) wv[u] = *(const u32x4*)(QA + (size_t)(it >> 4) * 3072 + (it & 15) * 192 + subc * 8); }
#pragma unroll
            for (int u = 0; u < 4; ++u) { const int it = it0 + u * G * 16; if (it < NT * 16) {
                const int row = it >> 4, hd = it & 15; u32x4* qp = (u32x4*)(QA + (size_t)row * 3072 + hd * 192 + subc * 8);
                const u32x4 w = wv[u];
                float v[8] = {bflo(w.x), bfhi(w.x), bflo(w.y), bfhi(w.y), bflo(w.z), bfhi(w.z), bflo(w.w), bfhi(w.w)};
                float ss = 0.f;
#pragma unroll
                for (int e2 = 0; e2 < 8; ++e2) ss += v[e2] * v[e2];
                const float rstd = rsqrtf(half_sum(sub < 24 ? ss : 0.f) * (1.0f / 192.0f) + EPS);
#pragma unroll
                for (int e2 = 0; e2 < 4; ++e2) { v[e2] *= rstd * ga[e2]; v[4 + e2] *= rstd * gb[e2]; }
                rope8(v, sub, row & 4095, true);
#pragma unroll
                for (int e2 = 0; e2 < 8; ++e2) v[e2] *= 0.10411754627145016f;
                u32x4 o; o.x = cvt_pk_bf16(v[0], v[1]); o.y = cvt_pk_bf16(v[2], v[3]); o.z = cvt_pk_bf16(v[4], v[5]); o.w = cvt_pk_bf16(v[6], v[7]);
                if (sub < 24) *qp = o; } }
        }
    }
    {
        bf16_t* CK = (bf16_t*)(p.ws + WS_CKV);
        const f32x4 ga = *(const f32x4*)(p.kv_norm_g + lane * 8), gb = *(const f32x4*)(p.kv_norm_g + lane * 8 + 4);
        for (int row0 = blockIdx.x * 8 + wid; row0 < NR; row0 += 4 * G * 8) {
            u32x4 wv[4];
#pragma unroll
            for (int u = 0; u < 4; ++u) { const int row = row0 + u * G * 8; if (row < NR) wv[u] = *(const u32x4*)(CK + (size_t)row * 512 + lane * 8); }
#pragma unroll
            for (int u = 0; u < 4; ++u) { const int row = row0 + u * G * 8; if (row < NR) {
                u32x4* pp = (u32x4*)(CK + (size_t)row * 512 + lane * 8); const u32x4 w = wv[u];
                f32x4 a = (f32x4){bflo(w.x), bfhi(w.x), bflo(w.y), bfhi(w.y)}, b = (f32x4){bflo(w.z), bfhi(w.z), bflo(w.w), bfhi(w.w)};
                const float rstd = rsqrtf(wave_sum(a[0] * a[0] + a[1] * a[1] + a[2] * a[2] + a[3] * a[3] + b[0] * b[0] + b[1] * b[1] + b[2] * b[2] + b[3] * b[3]) * (1.0f / 512.0f) + EPS);
                a = a * rstd * ga; b = b * rstd * gb;
                u32x4 o; o.x = cvt_pk_bf16(a[0], a[1]); o.y = cvt_pk_bf16(a[2], a[3]); o.z = cvt_pk_bf16(b[0], b[1]); o.w = cvt_pk_bf16(b[2], b[3]);
                *pp = o; } }
        }
    }
}
__device__ void phase_kfin(const Params& p) {
    const int tid = threadIdx.x, G = gridDim.x, lane = tid & 63, wid = tid >> 6;
    bf16_t* KB = (bf16_t*)(p.ws + WS_KB); const float* KRGT = (const float*)(p.ws + WS_KRGT);
    const int sub = lane & 31, subc = sub < 24 ? sub : 23;
    const f32x4 ga = *(const f32x4*)(p.k_norm_g + subc * 8), gb = *(const f32x4*)(p.k_norm_g + subc * 8 + 4);
    for (int it0 = (blockIdx.x * 8 + wid) * 2 + (lane >> 5); it0 < NR * 16; it0 += 8 * G * 16) {
        f32x4 la[8], lb[8];
#pragma unroll
        for (int u = 0; u < 8; ++u) lb[u] = (f32x4){0.f, 0.f, 0.f, 0.f};
#pragma unroll
        for (int u = 0; u < 8; ++u) { const int it = it0 + u * G * 16; if (it < NR * 16) {
            const int orow = it >> 4, hd = it & 15; const int b = orow / SKV, j = orow - b * SKV; const int grow = j < CL ? NT + b * CL + j : b * SEQ + (j - CL);
            if (sub < 16) { const u32x4 w = *(const u32x4*)(KB + (size_t)orow * 3072 + hd * 192 + subc * 8); la[u] = __builtin_bit_cast(f32x4, w); }
            else { const float* kr = KRGT + (size_t)grow * 96 + (subc - 16) * 8; la[u] = *(const f32x4*)kr; lb[u] = *(const f32x4*)(kr + 4); } } }
#pragma unroll
        for (int u = 0; u < 8; ++u) { const int it = it0 + u * G * 16; if (it < NR * 16) {
            const int orow = it >> 4, hd = it & 15; const int b = orow / SKV, j = orow - b * SKV; const bool isctx = j < CL;
            u32x4* kp = (u32x4*)(KB + (size_t)orow * 3072 + hd * 192 + subc * 8);
            float v[8] = {la[u][0], la[u][1], la[u][2], la[u][3], lb[u][0], lb[u][1], lb[u][2], lb[u][3]};
            if (sub < 16) { const u32x4 w = __builtin_bit_cast(u32x4, la[u]); v[0] = bflo(w.x); v[1] = bfhi(w.x); v[2] = bflo(w.y); v[3] = bfhi(w.y); v[4] = bflo(w.z); v[5] = bfhi(w.z); v[6] = bflo(w.w); v[7] = bfhi(w.w); }
            float ss = 0.f;
#pragma unroll
            for (int e2 = 0; e2 < 8; ++e2) ss += v[e2] * v[e2];
            const float rstd = rsqrtf(half_sum(sub < 24 ? ss : 0.f) * (1.0f / 192.0f) + EPS);
#pragma unroll
            for (int e2 = 0; e2 < 4; ++e2) { v[e2] *= rstd * ga[e2]; v[4 + e2] *= rstd * gb[e2]; }
            rope8(v, sub, j - CL, !isctx);
            u32x4 o; o.x = cvt_pk_bf16(v[0], v[1]); o.y = cvt_pk_bf16(v[2], v[3]); o.z = cvt_pk_bf16(v[4], v[5]); o.w = cvt_pk_bf16(v[6], v[7]);
            if (sub < 24) *kp = o; } }
    }
}
namespace att {
constexpr int DQ = 192, NW = 8, QBLK = 32, KVBLK = 64;
constexpr float SCALE = 0.07216878364870322f;
constexpr float THR = 8.f;
constexpr int LDQ = 3072, LDK = 3072, LDV = 2048, LDO = 2048;
constexpr int SDEPTH = 1;
constexpr int SHM_V = KVBLK * 128 * 2, SHM_K = KVBLK * DQ * 2, SHM_ATTN = 3 * SHM_V + 3 * SHM_K + NW * 64 * 4;
#define KSWZ(row, colB) ((row) * 384 + ((colB) ^ (((row) & 7) << 4)))
#define SBAR() __builtin_amdgcn_sched_barrier(0)
__device__ __forceinline__ int crow(int r, int hi) { return (r & 3) + 8 * (r >> 2) + 4 * hi; }
__device__ __forceinline__ void softmaxP(f32x16& p0, f32x16& p1, float& l_reg, bf16x8& pa0, bf16x8& pa1, bf16x8& pa2, bf16x8& pa3) {
  for (int r = 0; r < 16; ++r) p0[r] = __builtin_amdgcn_exp2f(p0[r]);
  for (int r = 0; r < 16; ++r) p1[r] = __builtin_amdgcn_exp2f(p1[r]);
  float ps = 0; for (int r = 0; r < 16; ++r) ps += p0[r]; for (int r = 0; r < 16; ++r) ps += p1[r];
  { auto rr = __builtin_amdgcn_permlane32_swap(__float_as_uint(ps), __float_as_uint(ps), false, false);
    ps = __uint_as_float(rr[0]) + __uint_as_float(rr[1]); }
  l_reg += ps;
#define PK4(P, BASE, OUT) do { unsigned a0 = cvt_pk_bf16(P[BASE + 0], P[BASE + 1]), a1 = cvt_pk_bf16(P[BASE + 2], P[BASE + 3]);   \
    unsigned b0 = cvt_pk_bf16(P[BASE + 4], P[BASE + 5]), b1 = cvt_pk_bf16(P[BASE + 6], P[BASE + 7]);                              \
    auto r0 = __builtin_amdgcn_permlane32_swap(a0, b0, false, false); auto r1 = __builtin_amdgcn_permlane32_swap(a1, b1, false, false); \
    u32x4 w = {r0[0], r1[0], r0[1], r1[1]}; OUT = *reinterpret_cast<bf16x8*>(&w); } while (0)
  PK4(p0, 0, pa0); PK4(p0, 8, pa1); PK4(p1, 0, pa2); PK4(p1, 8, pa3);
#undef PK4
}
__device__ __forceinline__ void qkt(f32x16& p0, f32x16& p1, const char* Ks, const bf16x8* qr, const char* qrl, int r32, int hi) {
  for (int r = 0; r < 16; ++r) { p0[r] = 0.f; p1[r] = 0.f; }
#pragma unroll
  for (int d0 = 0; d0 < 12; ++d0) { int cb = (d0 * 16 + hi * 8) * 2;
    bf16x8 b0 = *reinterpret_cast<const bf16x8*>(Ks + KSWZ(r32, cb));
    bf16x8 b1 = *reinterpret_cast<const bf16x8*>(Ks + KSWZ(32 + r32, cb));
    const bf16x8 qf = d0 < 10 ? qr[d0] : *reinterpret_cast<const bf16x8*>(qrl + (d0 - 10) * 1024);
    p0 = __builtin_amdgcn_mfma_f32_32x32x16_bf16(b0, qf, p0, 0, 0, 0);
    p1 = __builtin_amdgcn_mfma_f32_32x32x16_bf16(b1, qf, p1, 0, 0, 0); }
}
__device__ __forceinline__ int v_st(int k, int c) { const int kk = (k & ~0xC) | ((k & 4) << 1) | ((k & 8) >> 1); return ((kk >> 3) * 4 + (c >> 5)) * 512 + ((kk & 7) * 32 + (c & 31)) * 2; }
__device__ __forceinline__ int v_rd_base(int lane) { return ((lane & 3) << 3) | (((lane >> 2) & 3) << 6) | (((lane >> 4) & 1) << 5) | (((lane >> 5) & 1) << 8); }
constexpr int v_rd_off(int d0, int ks, int half) { return d0 * 512 + ks * 4096 + half * 2048; }
template <int OFF> __device__ __forceinline__ s16x4 tr_read(int vb) {
  s16x4 r; asm volatile("ds_read_b64_tr_b16 %0, %1 offset:%2" : "=&v"(r) : "v"(vb), "i"(OFF) : "memory"); return r;
}
template <int D0> __device__ __forceinline__ void pv_one(f32x16& od, int vb, bf16x8 pa0, bf16x8 pa1, bf16x8 pa2, bf16x8 pa3) {
  const s16x4 l0 = tr_read<v_rd_off(D0, 0, 0)>(vb), h0 = tr_read<v_rd_off(D0, 0, 1)>(vb), l1 = tr_read<v_rd_off(D0, 1, 0)>(vb), h1 = tr_read<v_rd_off(D0, 1, 1)>(vb);
  const s16x4 l2 = tr_read<v_rd_off(D0, 2, 0)>(vb), h2 = tr_read<v_rd_off(D0, 2, 1)>(vb), l3 = tr_read<v_rd_off(D0, 3, 0)>(vb), h3 = tr_read<v_rd_off(D0, 3, 1)>(vb);
  asm volatile("s_waitcnt lgkmcnt(0)" ::: "memory"); SBAR();
#define PK(L, H) (bf16x8){L[0], L[1], L[2], L[3], H[0], H[1], H[2], H[3]}
  od = __builtin_amdgcn_mfma_f32_32x32x16_bf16(pa0, PK(l0, h0), od, 0, 0, 0);
  od = __builtin_amdgcn_mfma_f32_32x32x16_bf16(pa1, PK(l1, h1), od, 0, 0, 0);
  od = __builtin_amdgcn_mfma_f32_32x32x16_bf16(pa2, PK(l2, h2), od, 0, 0, 0);
  od = __builtin_amdgcn_mfma_f32_32x32x16_bf16(pa3, PK(l3, h3), od, 0, 0, 0);
#undef PK
}
__device__ __forceinline__ void pv_d0(f32x16* o, int vb, bf16x8 pa0, bf16x8 pa1, bf16x8 pa2, bf16x8 pa3) {
  pv_one<0>(o[0], vb, pa0, pa1, pa2, pa3); pv_one<1>(o[1], vb, pa0, pa1, pa2, pa3); pv_one<2>(o[2], vb, pa0, pa1, pa2, pa3); pv_one<3>(o[3], vb, pa0, pa1, pa2, pa3);
}
__device__ __forceinline__ void attn_body(const bf16_t* __restrict__ Qb, const bf16_t* __restrict__ Kh, const bf16_t* __restrict__ Vh, bf16_t* __restrict__ Ob, int seq, char* lds) {
  const int tid = threadIdx.x, wid = tid >> 6, lane = tid & 63, r32 = lane & 31, hi = lane >> 5;
  char* V_lds = lds; char* K_lds = lds + 3 * SHM_V;
  float* ws = (float*)(lds + 3 * SHM_V + 3 * SHM_K) + wid * 64; float* li_l = ws; float* al_l = ws + 32;
  float l_reg = 0; f32x16 o[4]; for (int d = 0; d < 4; ++d) for (int r = 0; r < 16; ++r) o[d][r] = 0.f;
  bf16x8 qr[10];
  const bf16_t* Qw = Qb + (long)(wid * QBLK + r32) * LDQ + hi * 8;
  char* qrl = lds + SHM_ATTN + wid * 2048 + lane * 16;
#pragma unroll
  for (int d0 = 0; d0 < 10; ++d0) qr[d0] = *reinterpret_cast<const bf16x8*>(Qw + d0 * 16);
#pragma unroll
  for (int d0 = 10; d0 < 12; ++d0) *reinterpret_cast<bf16x8*>(qrl + (d0 - 10) * 1024) = *reinterpret_cast<const bf16x8*>(Qw + d0 * 16);
  const int widu = __builtin_amdgcn_readfirstlane(wid);
  int koff[3], voff[2];
#pragma unroll
  for (int i = 0; i < 3; ++i) { const int u = (widu + 8 * i) * 64 + lane, row = u / 24, x = u % 24, c16 = x ^ (row & 7); koff[i] = row * LDK + c16 * 8; }
#pragma unroll
  for (int i = 0; i < 2; ++i) { const int u = (widu + 8 * i) * 64 + lane, sub = u >> 5, within = u & 31, kk = (sub >> 2) * 8 + (within >> 2), c = (sub & 3) * 32 + (within & 3) * 8;
    const int k = (kk & ~0xC) | ((kk & 4) << 1) | ((kk & 8) >> 1); voff[i] = k * LDV + c; }
  const LAS char* ldsl = (const LAS char*)lds;
  const int vb0 = (int)(uintptr_t)V_lds + v_rd_base(lane);
#define SDMA(b, k0) do { \
    _Pragma("unroll") for (int _i = 0; _i < 3; ++_i) __builtin_amdgcn_global_load_lds((const unsigned*)(Kh + (long)(k0) * LDK + koff[_i]), (LAS unsigned*)(ldsl + 3 * SHM_V + (b) * SHM_K + (widu + 8 * _i) * 1024), 16, 0, 0); \
    _Pragma("unroll") for (int _i = 0; _i < 2; ++_i) __builtin_amdgcn_global_load_lds((const unsigned*)(Vh + (long)(k0) * LDV + voff[_i]), (LAS unsigned*)(ldsl + (b) * SHM_V + (widu + 8 * _i) * 1024), 16, 0, 0); } while (0)
#define RESC(a) do { if (__any((a) < 1.f)) { if (hi == 0) al_l[r32] = (a); asm volatile("s_waitcnt lgkmcnt(0)" ::: "memory"); \
    for (int d = 0; d < 4; ++d) for (int r = 0; r < 16; ++r) o[d][r] *= al_l[crow(r, hi)]; } } while (0)
  f32x16 pA0, pA1, pB0, pB1; bf16x8 pa0, pa1, pa2, pa3; const int NTL = seq / KVBLK;
  SDMA(0, 0); SDMA(1, KVBLK); asm volatile("s_waitcnt vmcnt(0)" ::: "memory"); __syncthreads();
  qkt(pA0, pA1, K_lds, qr, qrl, r32, hi);
  int bp = 0, bc = 1, bn = 2;
  for (int j = 1; j + 1 < NTL; j += 2) {
    SDMA(bn, (j + 1) * KVBLK);
    SBAR(); qkt(pB0, pB1, K_lds + bc * SHM_K, qr, qrl, r32, hi); softmaxP(pA0, pA1, l_reg, pa0, pa1, pa2, pa3); SBAR();
    pv_d0(o, vb0 + bp * (int)SHM_V, pa0, pa1, pa2, pa3);
    asm volatile("s_waitcnt vmcnt(0)" ::: "memory"); __syncthreads();
    { const int t = bp; bp = bc; bc = bn; bn = t; }
    if (j + 2 < NTL) SDMA(bn, (j + 2) * KVBLK);
    SBAR(); qkt(pA0, pA1, K_lds + bc * SHM_K, qr, qrl, r32, hi); softmaxP(pB0, pB1, l_reg, pa0, pa1, pa2, pa3); SBAR();
    pv_d0(o, vb0 + bp * (int)SHM_V, pa0, pa1, pa2, pa3);
    asm volatile("s_waitcnt vmcnt(0)" ::: "memory"); __syncthreads();
    { const int t = bp; bp = bc; bc = bn; bn = t; }
  }
  SBAR(); qkt(pB0, pB1, K_lds + bc * SHM_K, qr, qrl, r32, hi); softmaxP(pA0, pA1, l_reg, pa0, pa1, pa2, pa3); SBAR();
  pv_d0(o, vb0 + bp * (int)SHM_V, pa0, pa1, pa2, pa3);
  softmaxP(pB0, pB1, l_reg, pa0, pa1, pa2, pa3); SBAR();
  pv_d0(o, vb0 + bc * (int)SHM_V, pa0, pa1, pa2, pa3);
  if (hi == 0) li_l[r32] = l_reg; asm volatile("s_waitcnt lgkmcnt(0)" ::: "memory");
  float rli[16];
#pragma unroll
  for (int r = 0; r < 16; ++r) rli[r] = __builtin_amdgcn_rcpf(li_l[crow(r, hi)]);
  bf16_t* Ow = Ob + (long)(wid * QBLK) * LDO;
  unsigned short zv[16][4];
#pragma unroll
  for (int r = 0; r < 16; ++r) { const int orow = crow(r, hi);
#pragma unroll
    for (int d0 = 0; d0 < 4; ++d0) zv[r][d0] = Ow[(long)orow * LDO + d0 * 32 + r32]; }
#pragma unroll
  for (int r = 0; r < 16; ++r) { const int orow = crow(r, hi);
#pragma unroll
    for (int d0 = 0; d0 < 4; ++d0) Ow[(long)orow * LDO + d0 * 32 + r32] = (bf16_t)(cvt_pk_bf16(o[d0][r] * rli[r] * bf2f(zv[r][d0]), 0.f) & 0xffff); }
  __syncthreads();
#undef SDMA
#undef RESC
}
template <int SCR> __device__ void phase_attn(const Params& p, unsigned char* smem, int nrep) {
  const int G = gridDim.x;
  const bf16_t* Q = (const bf16_t*)(p.ws + WS_QA); const bf16_t* K = (const bf16_t*)(p.ws + WS_KB); const bf16_t* V = (const bf16_t*)(p.ws + WS_V2); bf16_t* O = (bf16_t*)(p.ws + (SCR ? WS_U : WS_ZA));
  for (int item = blockIdx.x; item < 1024; item += G) {
    const int b = item >> 8, c = item & 255, xcd = c & 7, jj = c >> 3, h = 2 * xcd + (jj >> 4), qb = jj & 15;
    for (int rep = 0; rep < nrep; ++rep)
    attn_body(Q + ((size_t)b * SEQ + qb * 256) * LDQ + h * DQ, K + (size_t)b * SKV * LDK + h * DQ, V + (size_t)b * SKV * LDV + h * 128, (rep + 1 == nrep ? O : (bf16_t*)(p.ws + WS_U)) + ((size_t)b * SEQ + qb * 256) * LDO + h * 128, SKV, (char*)smem);
  }
}
}
constexpr int N_PHASES = 12;
#define XB_TMO      128
#define XB_XCNT(j)  (256  + 64 * (j))
#define XB_XSUB(j)  (1280 + 64 * (j))
#define XB_XGEN(j)  (2304 + 64 * (j))
#define XB_TOP      3328
#define XB_TOPGEN   3392
#define XCD_BAR_WORDS 3456
#define XB_SPIN_CAP (1u << 22)
__device__ __forceinline__ unsigned xb_ld(unsigned* p)              { return __hip_atomic_load(p, __ATOMIC_RELAXED, __HIP_MEMORY_SCOPE_AGENT); }
__device__ __forceinline__ unsigned xb_add(unsigned* p, unsigned v) { return __hip_atomic_fetch_add(p, v, __ATOMIC_RELAXED, __HIP_MEMORY_SCOPE_AGENT); }
__device__ __forceinline__ unsigned xb_xcc_id() { return (unsigned)__builtin_amdgcn_s_getreg((3 << 11) | 20) & 0xFu; }
#define XB_SPIN(cond, bar) do { unsigned _sp = 0; while (cond) { __builtin_amdgcn_s_sleep(1); \
    if ((++_sp & 255u) == 0u) { if (xb_ld(&(bar)[XB_TMO])) break; if (_sp > XB_SPIN_CAP) { atomicAdd(&(bar)[XB_TMO], 1u); break; } } } } while (0)
struct XcdBarrier { unsigned* bar; unsigned x; volatile LAS unsigned* st; };
__device__ __forceinline__ XcdBarrier xcd_barrier_post(unsigned* bar, volatile LAS unsigned* st) {
    XcdBarrier b; b.bar = bar; b.x = xb_xcc_id(); b.st = st;
    if (threadIdx.x == 0) (void)xb_add(&bar[XB_XCNT(b.x)], 1u);
    return b;
}
__device__ __forceinline__ void xcd_barrier_complete(unsigned* bar, unsigned x, unsigned& nloc, unsigned& nx) {
    const unsigned G = gridDim.x * gridDim.y * gridDim.z;
    unsigned sum, cnt, mine, sp = 0u;
    for (;;) {
        sum = 0u; cnt = 0u; mine = 0u;
#pragma unroll
        for (unsigned j = 0; j < 16; ++j) { const unsigned c = xb_ld(&bar[XB_XCNT(j)]); sum += c; cnt += (c > 0u) ? 1u : 0u; mine = (j == x) ? c : mine; }
        if (sum == G) break;
        __builtin_amdgcn_s_sleep(1);
        if ((++sp & 255u) == 0u) { if (xb_ld(&bar[XB_TMO])) break; if (sp > XB_SPIN_CAP) { atomicAdd(&bar[XB_TMO], 1u); break; } }
    }
    nloc = mine > 0u ? mine : 1u; nx = cnt > 0u ? cnt : 1u;
}
__device__ __forceinline__ void xcd_barrier(const XcdBarrier& b) {
    asm volatile("s_waitcnt vmcnt(0)" ::: "memory");
    __syncthreads();
    if (threadIdx.x == 0) {
        unsigned* bar = b.bar;
        __builtin_amdgcn_s_waitcnt(0);
        unsigned nloc = b.st[0], nx = b.st[1];
        if (nloc == 0u) { xcd_barrier_complete(bar, b.x, nloc, nx); b.st[0] = nloc; b.st[1] = nx; }
        const unsigned old = xb_add(&bar[XB_XSUB(b.x)], 1u);
        const unsigned gen = old / nloc;
        if (old + 1u == (gen + 1u) * nloc) {
            __builtin_amdgcn_fence(__ATOMIC_RELEASE, "agent");
            asm volatile("s_waitcnt vmcnt(0)" ::: "memory");
            const unsigned og = xb_add(&bar[XB_TOP], 1u);
            const unsigned tg = og / nx;
            if (og + 1u == (tg + 1u) * nx) xb_add(&bar[XB_TOPGEN], 1u);
            else XB_SPIN(xb_ld(&bar[XB_TOPGEN]) == tg, bar);
            __builtin_amdgcn_fence(__ATOMIC_ACQUIRE, "agent");
            xb_add(&bar[XB_XGEN(b.x)], 1u);
            asm volatile("s_waitcnt vmcnt(0)" ::: "memory");
        } else {
            XB_SPIN(xb_ld(&bar[XB_XGEN(b.x)]) == gen, bar);
            __builtin_amdgcn_fence(__ATOMIC_ACQUIRE, "agent");
            asm volatile("s_waitcnt vmcnt(0)" ::: "memory");
        }
    }
    __syncthreads();
}
__global__ void __launch_bounds__(NTHR) hybrid_block_fwd(Params p) {
    extern __shared__ __attribute__((aligned(16))) unsigned char smem[];
    cg::grid_group grid = cg::this_grid();
    const int lo = p.ph_lo, hi = p.ph_hi, G = gridDim.x, bid = blockIdx.x;
    LAS unsigned char* lds = (LAS unsigned char*)smem;
    volatile LAS unsigned* xst = (volatile LAS unsigned*)(lds + LDS_BYTES - 16);
    if (threadIdx.x < 4) xst[threadIdx.x] = 0u;
    __syncthreads();
    XcdBarrier xbar = xcd_barrier_post((unsigned*)(p.ws + WS_BAR), xst);
    if (hi - lo > 1) grid.sync();
    bf16_t* GM = (bf16_t*)p.out;
#ifndef PHMASK
#define PHMASK 0xFFFF
#endif
#define IN(k) (((PHMASK >> (k)) & 1) && lo <= (k) && (k) < hi)
#define SEAM(k) do { if (IN(k) && IN((k) + 1)) xcd_barrier(xbar); } while (0)
    if (IN(0)) phase_prep(p, smem);
    SEAM(0);
    if (IN(1)) phase_hrows(p, smem);
    SEAM(1);
    if (IN(2)) { pg8::Gemm g{(const bf16_t*)(p.ws + WS_H), (const bf16_t*)(p.ws + WS_WIN), 2048, LDH}; pg8::Order S; S.init(64, 71, 4, 15, G, bid); pg8::EpiG1 E{p.ws, GM}; pg8::gemm_phase(lds, g, S, E); }
    SEAM(2);
    if (IN(3)) ml::phase_conv(p);
    SEAM(3);
    if (IN(4)) ml::phase_mlstm(p, smem);
    SEAM(4);
    if (IN(5)) phase_elem(p);
    SEAM(5);
    if (IN(6)) { pg8::Gemm g{(const bf16_t*)(p.ws + WS_CKV), (const bf16_t*)(p.ws + WS_WUKV), 512, 512}; pg8::Order S; S.init(68, 16, 0, 1, G, bid); pg8::EpiG2 E{p.ws}; pg8::gemm_phase(lds, g, S, E); }
    SEAM(6);
    if (IN(7)) phase_kfin(p);
    SEAM(7);
    if (IN(8)) att::phase_attn<0>(p, smem, 1);
    SEAM(8);
    if (IN(9)) { pg8::Gemm g{(const bf16_t*)(p.ws + WS_GMZ), (const bf16_t*)(p.ws + WS_WPM), 2048, 2048}; pg8::Order S; S.init(64, 8, 0, 1, G, bid); pg8::EpiPM<0> E{(bf16_t*)(p.ws + WS_U), GM}; pg8::gemm_phase(lds, g, S, E); }
    if (IN(10)) { pg8::Gemm g{(const bf16_t*)(p.ws + WS_ZA), (const bf16_t*)(p.ws + WS_WPA), 2048, 2048}; pg8::Order S; S.init(64, 8, 0, 1, G, bid); pg8::EpiPM<1> E{(bf16_t*)(p.ws + WS_U), GM + (size_t)NT * 2048}; pg8::gemm_phase(lds, g, S, E); }
    SEAM(10);
    if (IN(11)) { pg8::Gemm g{(const bf16_t*)(p.ws + WS_U), (const bf16_t*)(p.ws + WS_WOUT), 2048, 2048}; pg8::Order S; S.init(64, 8, 0, 1, G, bid); pg8::EpiOut E{p.x, p.out, (const float*)(p.ws + WS_MOD) + 4096}; pg8::gemm_phase(lds, g, S, E); }
#undef IN
#undef SEAM
}

extern "C" void kernel_launch(void* const* d_in, const int* in_sizes, int n_in, void* d_out, int out_size, void* d_ws, size_t ws_size, hipStream_t stream) {
    static int grid = 0;
    if (grid == 0) {
        if (n_in != 20 || out_size != NT * DM || ws_size < WS_END) { fprintf(stderr, "kernel_launch: unexpected shapes (n_in %d out %d ws %zu need %zu)\n", n_in, out_size, ws_size, (size_t)WS_END); grid = -1; return; }
        int dev = 0, cus = 0, per_cu = 0;
        hipGetDevice(&dev); hipDeviceGetAttribute(&cus, hipDeviceAttributeMultiprocessorCount, dev);
        if (hipFuncSetAttribute((const void*)hybrid_block_fwd, hipFuncAttributeMaxDynamicSharedMemorySize, LDS_BYTES) != hipSuccess) { fprintf(stderr, "kernel_launch: hipFuncSetAttribute failed\n"); grid = -1; return; }
        if (hipOccupancyMaxActiveBlocksPerMultiprocessor(&per_cu, (const void*)hybrid_block_fwd, NTHR, LDS_BYTES) != hipSuccess || per_cu < 1) { fprintf(stderr, "kernel_launch: occupancy query gave %d\n", per_cu); per_cu = 1; }
        (void)hipGetLastError();
        grid = cus * per_cu;
    }
    if (grid < 0) return;
    Params p{};
    const float** f = (const float**)&p;
    for (int i = 0; i < 20; ++i) f[i] = (const float*)d_in[i];
    p.out = (float*)d_out; p.ws = (unsigned char*)d_ws;
    if (hipMemsetAsync((unsigned char*)d_ws + WS_BAR, 0, XCD_BAR_WORDS * 4, stream) != hipSuccess) { fprintf(stderr, "kernel_launch: memset failed\n"); return; }
    p.ph_lo = 0; p.ph_hi = N_PHASES;
    void* args[] = {&p};
    hipError_t e = hipLaunchCooperativeKernel((const void*)hybrid_block_fwd, dim3(grid), dim3(NTHR), args, LDS_BYTES, stream);
    if (e != hipSuccess) fprintf(stderr, "kernel_launch: cooperative launch failed: %s (grid %d)\n", hipGetErrorString(e), grid);
}
```
